# Optimizing an MI355X kernel written in HIP

```python
import math
import jax, jax.numpy as jnp
from jax import lax
import numpy as np

D_MODEL = 2048
BATCH = 4
SEQ = 4096
DEPTH = 1

HEAD_DIM = 128
N_MEM = 256
GRID_W = 64
DIL_PAIRS = ((128, 1), (512, 4), (2048, 16))
A_HEADS_PER_GROUP = 2
A_HEADS = A_HEADS_PER_GROUP * len(DIL_PAIRS)
A_BLOCK = 64
B_Q_HEADS = 6
B_KV_HEADS = 2
B_QBLOCK = 128
ROPE_THETA = 10000.0
C_HEADS = 4
N_BRANCH = 3
REL_BUCKETS = 32
REL_MAX_DIST = 1024
D_FF = -(-8 * D_MODEL // (3 * 256)) * 256
EPS = 1e-6
NEG = -1e30

A_W = A_HEADS * HEAD_DIM
A_OUT_W = A_HEADS_PER_GROUP * HEAD_DIM
B_QW = B_Q_HEADS * HEAD_DIM
B_KVW = B_KV_HEADS * HEAD_DIM
C_W = C_HEADS * HEAD_DIM
IN_SPLITS = (A_W, A_W, A_W, B_QW, B_KVW, B_KVW, C_W, N_BRANCH * D_MODEL)
IN_W = sum(IN_SPLITS)

kernel_name = "hybrid_gated_dilated_gqa_mem_encoder"


def rms_norm(x, g):
    xf = x.astype(jnp.float32)
    y = xf * lax.rsqrt(jnp.mean(xf * xf, axis=-1, keepdims=True) + EPS)
    return (y * g.astype(jnp.float32)).astype(x.dtype)


def split_heads(t, h):
    return t.reshape(t.shape[0], t.shape[1], h, HEAD_DIM)


def t5_bucket(rel):
    nb = REL_BUCKETS // 2
    ret = jnp.where(rel > 0, nb, 0)
    n = jnp.abs(rel)
    max_exact = nb // 2
    large = max_exact + (jnp.log(jnp.maximum(n, 1).astype(jnp.float32) / max_exact)
                         / math.log(REL_MAX_DIST / max_exact) * (nb - max_exact)).astype(jnp.int32)
    large = jnp.minimum(large, nb - 1)
    return ret + jnp.where(n < max_exact, n, large)


def dilated_group(q, k, v, bias_tab, window, dil):
    b, s, h, dh = q.shape
    L = s // dil
    radius = window // (2 * dil)
    n = b * dil

    def to_res(t):
        return t.reshape(b, L, dil, h, dh).transpose(0, 2, 1, 3, 4).reshape(n, L, h, dh)

    qr, kr, vr = to_res(q), to_res(k), to_res(v)
    nb = -(-L // A_BLOCK)
    lp = nb * A_BLOCK
    side = -(-radius // A_BLOCK)
    pad = side * A_BLOCK
    wk = (2 * side + 1) * A_BLOCK
    qb = jnp.pad(qr, ((0, 0), (0, lp - L), (0, 0), (0, 0))).reshape(n, nb, A_BLOCK, h, dh)

    def band(t):
        tp = jnp.pad(t, ((0, 0), (pad, lp - L + pad), (0, 0), (0, 0))).reshape(n, nb + 2 * side, A_BLOCK, h, dh)
        return jnp.concatenate([tp[:, i:i + nb] for i in range(2 * side + 1)], axis=2)

    kb, vb = band(kr), band(vr)
    rel = (jnp.arange(wk) - pad)[None, :] - jnp.arange(A_BLOCK)[:, None]
    bias = bias_tab[t5_bucket(rel * dil)].transpose(2, 0, 1).astype(jnp.float32)
    k_pos = jnp.arange(nb)[:, None] * A_BLOCK - pad + jnp.arange(wk)[None, :]
    valid = (jnp.abs(rel) <= radius)[None] & ((k_pos >= 0) & (k_pos < L))[:, None, :]
    sc = jnp.einsum('nbqhd,nbkhd->nbhqk', qb, kb, preferred_element_type=jnp.float32) / math.sqrt(dh)
    sc = jnp.where(valid[None, :, None], sc + bias[None, None], NEG)
    m = jnp.max(sc, axis=-1, keepdims=True)
    p = jnp.exp(sc - m)
    l = jnp.sum(p, axis=-1, keepdims=True)
    o = jnp.einsum('nbhqk,nbkhd->nbqhd', p, vb.astype(jnp.float32))
    o = o / l[..., 0].transpose(0, 1, 3, 2)[..., None]
    lse = (m + jnp.log(l))[..., 0].transpose(0, 1, 3, 2)
    o = o.reshape(n, lp, h, dh)[:, :L]
    lse = lse.reshape(n, lp, h)[:, :L]
    o = o.reshape(b, dil, L, h, dh).transpose(0, 2, 1, 3, 4).reshape(b, s, h, dh)
    lse = lse.reshape(b, dil, L, h).transpose(0, 2, 1, 3).reshape(b, s, h)
    return o, lse


def axial_rope_tables(s):
    rows = s // GRID_W
    r = jnp.repeat(jnp.arange(rows), GRID_W).astype(jnp.float32)
    c = jnp.tile(jnp.arange(GRID_W), rows).astype(jnp.float32)
    nf = HEAD_DIM // 4
    inv = ROPE_THETA ** (-jnp.arange(nf, dtype=jnp.float32) / nf)
    ang = jnp.concatenate([r[:, None] * inv, c[:, None] * inv], axis=-1)
    return jnp.cos(ang), jnp.sin(ang)


def apply_rope(x, cos, sin):
    b, s, h, dh = x.shape
    xf = x.astype(jnp.float32).reshape(b, s, h, dh // 2, 2)
    x0, x1 = xf[..., 0], xf[..., 1]
    c, sn = cos[None, :, None, :], sin[None, :, None, :]
    out = jnp.stack([x0 * c - x1 * sn, x0 * sn + x1 * c], axis=-1)
    return out.reshape(b, s, h, dh).astype(x.dtype)


def gqa_blocks(q, k, v):
    b, s, hq, dh = q.shape
    g = hq // B_KV_HEADS
    nblk = s // B_QBLOCK
    qb = q.reshape(b, nblk, B_QBLOCK, B_KV_HEADS, g, dh).transpose(1, 0, 2, 3, 4, 5)

    def one_block(qq):
        sc = jnp.einsum('bqkgd,bskd->bkgqs', qq, k, preferred_element_type=jnp.float32) / math.sqrt(dh)
        p = jax.nn.softmax(sc, axis=-1)
        return jnp.einsum('bkgqs,bskd->bqkgd', p, v.astype(jnp.float32)).astype(q.dtype)

    o = lax.map(one_block, qb)
    return o.transpose(1, 0, 2, 3, 4, 5).reshape(b, s, hq * dh)


def setup_inputs(seed: int = 0) -> dict:
    key = jax.random.key(seed)
    ks = jax.random.split(key, 24)
    f32 = jnp.float32

    def w(k, shape, fan_in):
        return jax.random.normal(k, shape, f32) * (fan_in ** -0.5)

    def gain(k, shape):
        return 1.0 + 0.05 * jax.random.normal(k, shape, f32)

    Dp = DEPTH
    return {
        "x": jax.random.normal(ks[0], (BATCH, SEQ, D_MODEL), f32),
        "mem": jax.random.normal(ks[1], (BATCH, N_MEM, D_MODEL), f32),
        "rel_bias": 0.5 * jax.random.normal(ks[2], (REL_BUCKETS, A_HEADS), f32),
        "g_mix": gain(ks[3], (Dp, D_MODEL)),
        "w_in": w(ks[4], (Dp, D_MODEL, IN_W), D_MODEL),
        "g_qa": gain(ks[5], (Dp, HEAD_DIM)),
        "g_ka": gain(ks[6], (Dp, HEAD_DIM)),
        "g_qb": gain(ks[7], (Dp, HEAD_DIM)),
        "g_kb": gain(ks[8], (Dp, HEAD_DIM)),
        "g_mem": gain(ks[9], (Dp, D_MODEL)),
        "w_mem_kv": w(ks[10], (Dp, D_MODEL, 2 * C_W), D_MODEL),
        "g_qc": gain(ks[11], (Dp, HEAD_DIM)),
        "g_kc": gain(ks[12], (Dp, HEAD_DIM)),
        "w_br_a": w(ks[13], (Dp, A_OUT_W, D_MODEL), A_OUT_W),
        "w_br_b": w(ks[14], (Dp, B_QW, D_MODEL), B_QW),
        "w_br_c": w(ks[15], (Dp, C_W, D_MODEL), C_W),
        "w_o": w(ks[16], (Dp, D_MODEL, D_MODEL), D_MODEL),
        "g_ffn": gain(ks[17], (Dp, D_MODEL)),
        "w_ffn_in": w(ks[18], (Dp, D_MODEL, 2 * D_FF), D_MODEL),
        "w_ffn_out": w(ks[19], (Dp, D_FF, D_MODEL), D_FF),
    }


def reference(x, mem, rel_bias, g_mix, w_in, g_qa, g_ka, g_qb, g_kb, g_mem, w_mem_kv,
              g_qc, g_kc, w_br_a, w_br_b, w_br_c, w_o, g_ffn, w_ffn_in, w_ffn_out):
    b, s, _ = x.shape
    cos, sin = axial_rope_tables(s)
    offs = np.cumsum((0,) + IN_SPLITS)
    for layer in range(DEPTH):
        h = rms_norm(x, g_mix[layer])
        proj = h @ w_in[layer]
        qa, ka, va, qb, kb, vb, qc, gt = [proj[..., offs[i]:offs[i + 1]] for i in range(len(IN_SPLITS))]

        qa = rms_norm(split_heads(qa, A_HEADS), g_qa[layer])
        ka = rms_norm(split_heads(ka, A_HEADS), g_ka[layer])
        va = split_heads(va, A_HEADS)
        outs, lses = [], []
        for gi, (win, dil) in enumerate(DIL_PAIRS):
            sl = slice(gi * A_HEADS_PER_GROUP, (gi + 1) * A_HEADS_PER_GROUP)
            o, lse = dilated_group(qa[:, :, sl], ka[:, :, sl], va[:, :, sl], rel_bias[:, sl], win, dil)
            outs.append(o)
            lses.append(lse)
        wgt = jax.nn.softmax(jnp.stack(lses), axis=0)
        oa = jnp.sum(wgt[..., None] * jnp.stack(outs), axis=0).reshape(b, s, A_OUT_W).astype(x.dtype)

        qb = apply_rope(rms_norm(split_heads(qb, B_Q_HEADS), g_qb[layer]), cos, sin)
        kb = apply_rope(rms_norm(split_heads(kb, B_KV_HEADS), g_kb[layer]), cos, sin)
        ob = gqa_blocks(qb, kb, split_heads(vb, B_KV_HEADS))

        mkv = rms_norm(mem, g_mem[layer]) @ w_mem_kv[layer]
        kc = rms_norm(split_heads(mkv[..., :C_W], C_HEADS), g_kc[layer])
        vc = split_heads(mkv[..., C_W:], C_HEADS)
        qc = rms_norm(split_heads(qc, C_HEADS), g_qc[layer])
        sc = jnp.einsum('bqhd,bmhd->bhqm', qc, kc, preferred_element_type=jnp.float32) / math.sqrt(HEAD_DIM)
        pc = jax.nn.softmax(sc, axis=-1)
        oc = jnp.einsum('bhqm,bmhd->bqhd', pc, vc.astype(jnp.float32)).reshape(b, s, C_W).astype(x.dtype)

        gates = jax.nn.sigmoid(gt.astype(jnp.float32)).reshape(b, s, N_BRANCH, D_MODEL)
        merged = (gates[:, :, 0] * (oa @ w_br_a[layer]).astype(jnp.float32)
                  + gates[:, :, 1] * (ob @ w_br_b[layer]).astype(jnp.float32)
                  + gates[:, :, 2] * (oc @ w_br_c[layer]).astype(jnp.float32)).astype(x.dtype)
        x = x + merged @ w_o[layer]

        hf = rms_norm(x, g_ffn[layer]) @ w_ffn_in[layer]
        x = x + (jax.nn.silu(hf[..., :D_FF]) * hf[..., D_FF:]) @ w_ffn_out[layer]
    return x
```

```cpp
#include <hip/hip_runtime.h>
#include <cstdio>
#include <cstdint>

#ifndef MK_N_LAUNCHES
#define MK_N_LAUNCHES 1
#endif

#ifndef WGM_BIG
#define WGM_BIG 2
#endif
#ifndef WGM_SMALL
#define WGM_SMALL 2
#endif
#ifndef PROBE_DUP
#define PROBE_DUP -1
#endif
#define LAS __attribute__((address_space(3)))
#define GAS __attribute__((address_space(1)))
typedef unsigned short bf16_t;
typedef short bf16x8 __attribute__((ext_vector_type(8)));
typedef float f32x4 __attribute__((ext_vector_type(4)));
typedef float f32x2 __attribute__((ext_vector_type(2)));
typedef float f32x16 __attribute__((ext_vector_type(16)));
typedef unsigned u32x4 __attribute__((ext_vector_type(4)));
typedef unsigned u32x2 __attribute__((ext_vector_type(2)));
typedef __bf16 bf16x2_t __attribute__((ext_vector_type(2)));

constexpr int NB = 4, SEQ = 4096, DM = 2048, T = NB * SEQ, HD = 128, NMEM = 256, TM = NB * NMEM;
constexpr int INW = 10240, QKVW = 4096, GATEW = 6144, DFF = 5632;
constexpr int OALLW = 1536, O_A = 0, O_B = 256, O_C = 1024;
constexpr int C_QA = 0, C_KA = 768, C_VA = 1536, C_QB = 2304, C_KB = 3072, C_VB = 3328, C_QC = 3584;
constexpr float EPS = 1e-6f;
constexpr float LOG2E = 1.4426950408889634f;
constexpr float QSCALE = 0.08838834764831845f * LOG2E;

constexpr size_t MiB = 1u << 20;
constexpr size_t WS_CTL = 0, CTL_ZERO_BYTES = 1 * MiB;
constexpr size_t WS_SSQ = 512 * 1024;
constexpr size_t WS_ROPE = 1 * MiB;
constexpr size_t WS_BIAS = 1 * MiB + 65536;
constexpr size_t WS_LSE = 2 * MiB;
constexpr size_t WS_WIN = 4 * MiB;
constexpr size_t WS_WMKV = 44 * MiB;
constexpr size_t WS_WBR = 48 * MiB;
constexpr size_t WS_WO = 54 * MiB;
constexpr size_t WS_WFO = 62 * MiB;
constexpr size_t WS_WFI = 452 * MiB;
constexpr size_t WS_QKV = 84 * MiB;
constexpr size_t WS_GATES = 212 * MiB;
constexpr size_t WS_OALL = 404 * MiB;
constexpr size_t WS_END = 496 * MiB;
constexpr size_t DO_HB = 0;
constexpr size_t DO_OG = 64 * MiB;
constexpr size_t DO_MEMN = 88 * MiB;
constexpr size_t DO_MKV = 92 * MiB;
constexpr int CW_BAR = 4096;

__device__ __forceinline__ unsigned cvtpk(float lo, float hi) { f32x2 v = {lo, hi}; bf16x2_t b = __builtin_convertvector(v, bf16x2_t); return __builtin_bit_cast(unsigned, b); }
__device__ __forceinline__ float bf_lo(unsigned w) { return __builtin_bit_cast(float, w << 16); }
__device__ __forceinline__ float bf_hi(unsigned w) { return __builtin_bit_cast(float, w & 0xffff0000u); }
__device__ __forceinline__ float bf2f(bf16_t h) { return __builtin_bit_cast(float, (unsigned)h << 16); }
__device__ __forceinline__ float wave_sum(float v) {
#pragma unroll
    for (int o = 1; o < 64; o <<= 1) v += __shfl_xor(v, o);
    return v;
}
#define LDS_WAIT() asm volatile("s_waitcnt lgkmcnt(0)" ::: "memory")
#define VM_WAIT() asm volatile("s_waitcnt vmcnt(0)" ::: "memory")

struct Args { const float* in[20]; float* out; unsigned char* ws; int ph_lo, ph_hi; };
struct Frame {
    LAS unsigned char* lds;
    const __attribute__((address_space(4))) Args* a;
    GAS unsigned char* ws; GAS float* out;
    int tid, lane, wave, vcu, G;
};
#define F_x         ((const float*)(const GAS float*)F.a->in[0])
#define F_mem       ((const float*)(const GAS float*)F.a->in[1])
#define F_rel_bias  ((const float*)(const GAS float*)F.a->in[2])
#define F_g_mix     ((const float*)(const GAS float*)F.a->in[3])
#define F_w_in      ((const float*)(const GAS float*)F.a->in[4])
#define F_g_qa      ((const float*)(const GAS float*)F.a->in[5])
#define F_g_ka      ((const float*)(const GAS float*)F.a->in[6])
#define F_g_qb      ((const float*)(const GAS float*)F.a->in[7])
#define F_g_kb      ((const float*)(const GAS float*)F.a->in[8])
#define F_g_mem     ((const float*)(const GAS float*)F.a->in[9])
#define F_w_mem_kv  ((const float*)(const GAS float*)F.a->in[10])
#define F_g_qc      ((const float*)(const GAS float*)F.a->in[11])
#define F_g_kc      ((const float*)(const GAS float*)F.a->in[12])
#define F_w_br_a    ((const float*)(const GAS float*)F.a->in[13])
#define F_w_br_b    ((const float*)(const GAS float*)F.a->in[14])
#define F_w_br_c    ((const float*)(const GAS float*)F.a->in[15])
#define F_w_o       ((const float*)(const GAS float*)F.a->in[16])
#define F_g_ffn     ((const float*)(const GAS float*)F.a->in[17])
#define F_w_ffn_in  ((const float*)(const GAS float*)F.a->in[18])
#define F_w_ffn_out ((const float*)(const GAS float*)F.a->in[19])
#define F_ctl   ((unsigned*)(GAS unsigned*)(F.ws + WS_CTL))
#define F_ssq   ((float*)(GAS float*)(F.ws + WS_SSQ))
#define F_rope  ((f32x2*)(GAS f32x2*)(F.ws + WS_ROPE))
#define F_biasT ((float*)(GAS float*)(F.ws + WS_BIAS))
#define F_lse   ((float*)(GAS float*)(F.ws + WS_LSE))
#define F_Win   ((bf16_t*)(GAS bf16_t*)(F.ws + WS_WIN))
#define F_Wmkv  ((bf16_t*)(GAS bf16_t*)(F.ws + WS_WMKV))
#define F_Wbr   ((bf16_t*)(GAS bf16_t*)(F.ws + WS_WBR))
#define F_Wo    ((bf16_t*)(GAS bf16_t*)(F.ws + WS_WO))
#define F_Wfo   ((bf16_t*)(GAS bf16_t*)(F.ws + WS_WFO))
#define F_Wfi   ((bf16_t*)(GAS bf16_t*)(F.ws + WS_WFI))
#define F_QKV   ((bf16_t*)(GAS bf16_t*)(F.ws + WS_QKV))
#define F_GATES ((bf16_t*)(GAS bf16_t*)(F.ws + WS_GATES))
#define F_OALL  ((bf16_t*)(GAS bf16_t*)(F.ws + WS_OALL))
#define F_OG    ((bf16_t*)(GAS bf16_t*)((GAS unsigned char*)F.out + DO_OG))
#define F_HB1   ((bf16_t*)(GAS bf16_t*)((GAS unsigned char*)F.out + DO_HB))
#define F_HB2   F_HB1
#define HB_SPLIT 16384
#define F_MEMN  ((bf16_t*)(GAS bf16_t*)((GAS unsigned char*)F.out + DO_MEMN))
#define F_MKV   ((bf16_t*)(GAS bf16_t*)((GAS unsigned char*)F.out + DO_MKV))
#define F_X1B   ((bf16_t*)(GAS bf16_t*)(F.ws + WS_QKV))
#define F_ACT   ((bf16_t*)(GAS bf16_t*)(F.ws + WS_GATES))
#define F_out   ((float*)F.out)

namespace pg8 {
constexpr int BM = 256, BK = 64, HALF = 128, HTB = HALF * BK * 2, STAGE_BYTES = 8 * HTB, NXCD = 8;
__host__ __device__ __forceinline__ int lds_byte(int r, int c) { const int st = (r >> 4) * 2 + (c >> 5), rr = r & 15, cc = c & 31, ob = rr * 64 + cc * 2; return st * 1024 + (ob ^ (((ob >> 9) & 1) << 5)); }
__host__ __device__ __forceinline__ void stage_rc(int b, int& R, int& C) { const int st = b / 1024, sb = b % 1024, swz = sb ^ (((sb >> 9) & 1) << 5); R = (st >> 1) * 16 + swz / 64; C = (st & 1) * 32 + (swz % 64) / 2; }
__host__ __device__ __forceinline__ int perm32(int rho) { const int n = rho >> 4, i = rho & 15; return 8 * (i >> 2) + 4 * n + (i & 3); }

struct Unit { int pm, pn, br; };
struct Gemm { const bf16_t* A; const bf16_t* Bt; int lda, ldb, M, N, K; const bf16_t* A2; int pm_split; int nbr; };
struct StaticOrder {
    int nM, nN, nwg, G, c, WGM, nbr;
    __device__ void init(int M, int N, int G_, int c_, int wgm_) { nM = M / BM; nN = N / BM; nwg = nM * nN; G = G_; c = c_; WGM = wgm_; nbr = 1; }
    __device__ bool next(int i, Unit& u) const {
        const int ti = (nbr == 3) ? i / 3 : i; u.br = i - ti * nbr;
        const long L = (long)ti * G + c; if (L >= nwg) return false;
        int wgid = (int)L; { const int q = nwg / NXCD, r = nwg % NXCD, xcd = wgid % NXCD, off = wgid / NXCD; wgid = (xcd < r ? xcd * (q + 1) : r * (q + 1) + (xcd - r) * q) + off; }
        const int nig = WGM * nN, gid = wgid / nig, fm = gid * WGM, gsz = (nM - fm) < WGM ? (nM - fm) : WGM;
        u.pm = fm + ((wgid % nig) % gsz); u.pn = (wgid % nig) / gsz; return true;
    }
};

template <class Epi>
__device__ __forceinline__ void gemm_phase(LAS unsigned char* lds, const Gemm g, const StaticOrder& S, const Epi& E, const int tid) {
    const int wid = __builtin_amdgcn_readfirstlane(tid >> 6), lane = tid & 63, wr = wid >> 2, wc = wid & 3, fr = lane & 15, fq = lane >> 4;
    const int K = g.K;
#define PG8_K0(u_) ((g.nbr == 3) ? ((u_).br == 0 ? 0 : ((u_).br == 1 ? 4 : 16)) : 0)
#define PG8_NT(u_) ((g.nbr == 3) ? ((u_).br == 0 ? 4 : ((u_).br == 1 ? 12 : 8)) : K / BK)
    unsigned voffA, voffB;
    { int R, C; stage_rc(tid * 16, R, C); const int Rb = (R & ~31) + perm32(R & 31); voffA = (unsigned)(R * g.lda + C) * 2u; voffB = (unsigned)(Rb * g.ldb + C) * 2u; }
    const size_t rstep_voffA = (size_t)64 * g.lda * 2, rstep_voffB = (size_t)64 * g.ldb * 2;
    const size_t kstep = (size_t)(BK * 2);
    const size_t hstepA = (size_t)HALF * g.lda * 2, hstepB = (size_t)HALF * g.ldb * 2;
    const size_t tstepA = 2 * hstepA, tstepB = 2 * hstepB;
    const unsigned ldsw = (unsigned)wid * 1024u;
    const int aoff = lds_byte(wr * 64 + fr, fq * 8), boff = lds_byte(wc * 32 + fr, fq * 8);
#define PG8_SA(b, h) (((b) * 2 + (h)) * HTB)
#define PG8_SB(b, h) ((4 + (b) * 2 + (h)) * HTB)
#define PG8_STAGE_(bufoff, gbase, voff, rstep) do { _Pragma("unroll") for (int _i = 0; _i < 2; ++_i) \
        __builtin_amdgcn_global_load_lds((const unsigned*)((const char*)(gbase) + (size_t)_i * (rstep) + (voff)), (LAS unsigned*)(lds + (bufoff) + ldsw + _i * 8192), 16, 0, 0); } while (0)
#define PG8_STAGE(bufoff, gbase, voff) PG8_STAGE_(bufoff, gbase, voff, rstep_##voff)
#define PG8_LDA(dst, b, h) do { _Pragma("unroll") for (int m = 0; m < 4; ++m) _Pragma("unroll") for (int k = 0; k < 2; ++k) dst[m][k] = *(const LAS bf16x8*)(lds + PG8_SA(b, h) + aoff + m * 2048 + k * 1024); } while (0)
#define PG8_LDB(dst, b, h) do { _Pragma("unroll") for (int n = 0; n < 2; ++n) _Pragma("unroll") for (int k = 0; k < 2; ++k) dst[n][k] = *(const LAS bf16x8*)(lds + PG8_SB(b, h) + boff + n * 2048 + k * 1024); } while (0)
#define PG8_MMA(ai, bj, At, Bt) do { __builtin_amdgcn_s_setprio(1); _Pragma("unroll") for (int m = 0; m < 4; ++m) _Pragma("unroll") for (int n = 0; n < 2; ++n) _Pragma("unroll") for (int k = 0; k < 2; ++k) \
        acc[ai][bj][m][n] = __builtin_amdgcn_mfma_f32_16x16x32_bf16(Bt[n][k], At[m][k], acc[ai][bj][m][n], 0, 0, 0); __builtin_amdgcn_s_setprio(0); } while (0)
#define PG8_WAIT_V(n) asm volatile("s_waitcnt vmcnt(" #n ")" ::: "memory")
#define PG8_WAIT_L(n) asm volatile("s_waitcnt lgkmcnt(" #n ")" ::: "memory")
#define PG8_BAR __builtin_amdgcn_s_barrier()
#define PG8_SCHED __builtin_amdgcn_sched_barrier(0)
    Unit cur, nxt; int ui = 0;
    if (!S.next(0, cur)) return;
    f32x4 acc[2][2][4][2];
#pragma unroll
    for (int a = 0; a < 2; ++a)
#pragma unroll
        for (int b = 0; b < 2; ++b)
#pragma unroll
            for (int m = 0; m < 4; ++m)
#pragma unroll
                for (int n = 0; n < 2; ++n) acc[a][b][m][n] = (f32x4){0.f, 0.f, 0.f, 0.f};
    bf16x8 At[4][2], B0[2][2], B1[2][2];
#define PG8_AOF(pm_) ((pm_) < g.pm_split ? (const char*)g.A + (size_t)(pm_) * tstepA : (const char*)g.A2 + (size_t)((pm_) - g.pm_split) * tstepA)
    int nt = PG8_NT(cur);
    const char* cA = PG8_AOF(cur.pm) + (size_t)PG8_K0(cur) * kstep; const char* cB = (const char*)g.Bt + (size_t)cur.pn * tstepB + (size_t)PG8_K0(cur) * kstep;
    PG8_STAGE(PG8_SB(0, 0), cB, voffB); PG8_STAGE(PG8_SB(0, 1), cB + hstepB, voffB); PG8_STAGE(PG8_SA(0, 0), cA, voffA); PG8_STAGE(PG8_SA(0, 1), cA + hstepA, voffA);
    if (wr == 1) PG8_BAR;
    PG8_WAIT_V(2); PG8_BAR;
    PG8_STAGE(PG8_SB(1, 0), cB + kstep, voffB); PG8_STAGE(PG8_SA(1, 0), cA + kstep, voffA); PG8_STAGE(PG8_SB(1, 1), cB + hstepB + kstep, voffB);
    PG8_WAIT_V(6); PG8_BAR;
    for (;;) {
        const bool has_next = S.next(ui + 1, nxt);
        const char* nA = has_next ? PG8_AOF(nxt.pm) + (size_t)PG8_K0(nxt) * kstep : cA; const char* nB = has_next ? (const char*)g.Bt + (size_t)nxt.pn * tstepB + (size_t)PG8_K0(nxt) * kstep : cB;
        for (int t = 0; t < nt; t += 2) {
            const bool last = (t == nt - 2);
            const char* a1 = cA + (size_t)(t + 1) * kstep;
            const char* a2 = last ? nA : cA + (size_t)(t + 2) * kstep; const char* b2 = last ? nB : cB + (size_t)(t + 2) * kstep;
            const char* a3 = a2 + kstep; const char* b3 = b2 + kstep;
            PG8_LDB(B0, 0, 0); PG8_LDB(B1, 0, 1); PG8_SCHED; PG8_LDA(At, 0, 0); PG8_STAGE(PG8_SA(1, 1), a1 + hstepA, voffA);
            PG8_WAIT_V(8); PG8_WAIT_L(0); PG8_BAR; PG8_MMA(0, 0, At, B0); PG8_MMA(0, 1, At, B1); PG8_BAR; PG8_SCHED;
            PG8_LDA(At, 0, 1); PG8_STAGE(PG8_SB(0, 0), b2, voffB); PG8_STAGE(PG8_SB(0, 1), b2 + hstepB, voffB); PG8_STAGE(PG8_SA(0, 0), a2, voffA);
            PG8_WAIT_V(8); PG8_WAIT_L(0); PG8_BAR; PG8_MMA(1, 0, At, B0); PG8_MMA(1, 1, At, B1); PG8_BAR; PG8_SCHED;
            PG8_LDB(B0, 1, 0); PG8_LDB(B1, 1, 1); PG8_SCHED; PG8_LDA(At, 1, 0); PG8_STAGE(PG8_SA(0, 1), a2 + hstepA, voffA);
            PG8_WAIT_V(8); PG8_WAIT_L(0); PG8_BAR; PG8_MMA(0, 0, At, B0); PG8_MMA(0, 1, At, B1); PG8_BAR; PG8_SCHED;
            PG8_LDA(At, 1, 1); PG8_STAGE(PG8_SB(1, 0), b3, voffB); PG8_STAGE(PG8_SB(1, 1), b3 + hstepB, voffB); PG8_STAGE(PG8_SA(1, 0), a3, voffA);
            PG8_WAIT_V(8); PG8_WAIT_L(0); PG8_BAR; PG8_MMA(1, 0, At, B0); PG8_MMA(1, 1, At, B1); PG8_BAR; PG8_SCHED;
            if (E.hook_at(t + 2)) E.hook(acc, cur, t + 2, wr, wc, fr, fq);
        }
        if (wr == 0) PG8_BAR;
        E(acc, cur, wr, wc, fr, fq);
        if (!has_next) break;
#pragma unroll
        for (int a = 0; a < 2; ++a)
#pragma unroll
            for (int b = 0; b < 2; ++b)
#pragma unroll
                for (int m = 0; m < 4; ++m)
#pragma unroll
                    for (int n = 0; n < 2; ++n) acc[a][b][m][n] = (f32x4){0.f, 0.f, 0.f, 0.f};
        cur = nxt; cA = nA; cB = nB; nt = PG8_NT(cur); ++ui;
        if (wr == 1) PG8_BAR;
    }
    PG8_WAIT_V(0);
    PG8_BAR;
#undef PG8_SA
#undef PG8_SB
#undef PG8_STAGE
#undef PG8_STAGE_
#undef PG8_AOF
#undef PG8_K0
#undef PG8_NT
#undef PG8_LDA
#undef PG8_LDB
#undef PG8_MMA
#undef PG8_WAIT_V
#undef PG8_WAIT_L
#undef PG8_BAR
#undef PG8_SCHED
}
}

constexpr int RING_BYTES = 131072, LDSCTL_OFF = RING_BYTES, XCH_OFF = RING_BYTES + 1024, LDS_BYTES = 147456;
enum EpiMode { E_PROJ = 0, E_MKV, E_BR, E_WO, E_FFI, E_FFO };
__device__ __forceinline__ float sigmoidf_(float v) { return __builtin_amdgcn_rcpf(1.0f + __builtin_amdgcn_exp2f(-v * LOG2E)); }
__device__ __forceinline__ float sum_fq(float s) {
    s += __int_as_float(__builtin_amdgcn_ds_swizzle(__float_as_int(s), 0x401F));
    const auto rr = __builtin_amdgcn_permlane32_swap(__float_as_uint(s), __float_as_uint(s), false, false);
    const unsigned x = rr[0], y = rr[1];
    return __uint_as_float(x) + __uint_as_float(y);
}
struct EpiRT {
    int mode; const Frame* Fp; bool dry;
    __device__ __forceinline__ bool hook_at(int kt) const { (void)kt; return false; }
    __device__ __forceinline__ void hook(f32x4 (&acc)[2][2][4][2], const pg8::Unit& u, int kt, int wr, int wc, int fr, int fq) const {
        const Frame& F = *Fp;
        int ln_ = (int)__builtin_amdgcn_mbcnt_hi(~0u, __builtin_amdgcn_mbcnt_lo(~0u, 0u)); asm volatile("" : "+v"(ln_));
        const int fr_ = ln_ & 15, fq_ = ln_ >> 4; (void)fr; (void)fq;
        const int rowb = u.pm * 256 + wr * 64 + fr_, colb = u.pn * 256 + wc * 32 + 8 * fq_, gi = (kt == 4) ? 0 : 1;
#pragma unroll
        for (int ai = 0; ai < 2; ++ai) {
            u32x4 ga[4][2], gb[4][2];
#pragma unroll
            for (int m = 0; m < 4; ++m)
#pragma unroll
                for (int bj = 0; bj < 2; ++bj) { const bf16_t* gp = F_GATES + (size_t)(rowb + ai * 128 + m * 16) * GATEW + gi * DM + colb + bj * 128; ga[m][bj] = *(const u32x4*)gp; gb[m][bj] = *(const u32x4*)(gp + DM); }
#pragma unroll
            for (int m = 0; m < 4; ++m)
#pragma unroll
                for (int bj = 0; bj < 2; ++bj) { const u32x4 a = ga[m][bj], b = gb[m][bj];
                    f32x4 r0, r1;
                    r0[0] = bf_lo(a.x) * __builtin_amdgcn_rcpf(bf_lo(b.x)); r0[1] = bf_hi(a.x) * __builtin_amdgcn_rcpf(bf_hi(b.x)); r0[2] = bf_lo(a.y) * __builtin_amdgcn_rcpf(bf_lo(b.y)); r0[3] = bf_hi(a.y) * __builtin_amdgcn_rcpf(bf_hi(b.y));
                    r1[0] = bf_lo(a.z) * __builtin_amdgcn_rcpf(bf_lo(b.z)); r1[1] = bf_hi(a.z) * __builtin_amdgcn_rcpf(bf_hi(b.z)); r1[2] = bf_lo(a.w) * __builtin_amdgcn_rcpf(bf_lo(b.w)); r1[3] = bf_hi(a.w) * __builtin_amdgcn_rcpf(bf_hi(b.w));
                    acc[ai][bj][m][0] *= r0; acc[ai][bj][m][1] *= r1; }
            asm volatile("" ::: "memory"); }
    }
    __device__ __forceinline__ void operator()(const f32x4 (&acc)[2][2][4][2], const pg8::Unit& u, int wr, int wc, int fr0, int fq0) const {
        const Frame& F = *Fp;
        int ln_ = (int)__builtin_amdgcn_mbcnt_hi(~0u, __builtin_amdgcn_mbcnt_lo(~0u, 0u)); asm volatile("" : "+v"(ln_));
        const int fr = ln_ & 15, fq = ln_ >> 4; (void)fr0; (void)fq0;
        const int rowb = u.pm * 256 + wr * 64 + fr, colb = u.pn * 256 + wc * 32 + 8 * fq;
        if (mode == E_PROJ || mode == E_MKV) {
            const bool gate = (mode == E_PROJ) && (u.pn >= 16);
            bf16_t* base; int ld, c0; const float* gptr = nullptr; bool rope = false; float sc = 1.f;
            if (mode == E_MKV) { base = F_MKV; ld = 1024; c0 = colb; if (u.pn < 2) gptr = F_g_kc; }
            else if (!gate) { base = F_QKV; ld = QKVW; c0 = colb; const int pn = u.pn;
                if (pn < 3) { gptr = F_g_qa; sc = QSCALE; } else if (pn < 6) gptr = F_g_ka; else if (pn < 9) {} else if (pn < 12) { gptr = F_g_qb; rope = true; sc = QSCALE; }
                else if (pn == 12) { gptr = F_g_kb; rope = true; } else if (pn == 13) {} else { gptr = F_g_qc; sc = QSCALE; } }
            else { base = F_GATES; ld = GATEW; c0 = colb - QKVW; }
            f32x4 g0 = {1.f, 1.f, 1.f, 1.f}, g1 = g0;
            LAS float* P = (LAS float*)(F.lds + XCH_OFF);
            if (gptr) {
#pragma unroll
                for (int ai = 0; ai < 2; ++ai)
#pragma unroll
                    for (int m = 0; m < 4; ++m)
#pragma unroll
                        for (int bj = 0; bj < 2; ++bj) { const f32x4 a = acc[ai][bj][m][0], b = acc[ai][bj][m][1];
                            float ss = (a[0] * a[0] + a[1] * a[1]) + (a[2] * a[2] + a[3] * a[3]) + (b[0] * b[0] + b[1] * b[1]) + (b[2] * b[2] + b[3] * b[3]);
                            ss = sum_fq(ss);
                            if (fq == 0) P[(ai * 128 + wr * 64 + m * 16 + fr) * 8 + bj * 4 + wc] = ss; }
                asm volatile("s_waitcnt lgkmcnt(0)" ::: "memory"); __builtin_amdgcn_s_barrier(); asm volatile("" ::: "memory");
                g0 = *(const f32x4*)(gptr + wc * 32 + 8 * fq); g1 = *(const f32x4*)(gptr + wc * 32 + 8 * fq + 4);
            }
#pragma unroll
            for (int ai = 0; ai < 2; ++ai)
#pragma unroll
                for (int m = 0; m < 4; ++m) { const int row = rowb + ai * 128 + m * 16; bf16_t* rowp = base + (size_t)row * ld + c0;
                    f32x4 cs0 = {1.f, 0.f, 1.f, 0.f}, cs1 = cs0;
                    if (rope) { const int s = row & (SEQ - 1), pos = (wc < 2) ? (s >> 6) : (s & 63); const float* rp = (const float*)(F_rope + pos * 32 + 16 * (wc & 1) + 4 * fq);
                        cs0 = *(const f32x4*)rp; cs1 = *(const f32x4*)(rp + 4); }
#pragma unroll
                    for (int bj = 0; bj < 2; ++bj) { f32x4 v0 = acc[ai][bj][m][0], v1 = acc[ai][bj][m][1];
                        if (gate) {
#pragma unroll
                            for (int j = 0; j < 4; ++j) { v0[j] = sigmoidf_(v0[j]); v1[j] = sigmoidf_(v1[j]); } }
                        else if (gptr) { const f32x4 q = *(const LAS f32x4*)(P + (ai * 128 + wr * 64 + m * 16 + fr) * 8 + bj * 4);
                            const float r = sc / sqrtf(((q[0] + q[1]) + (q[2] + q[3])) * (1.0f / HD) + EPS); v0 = v0 * g0 * r; v1 = v1 * g1 * r;
                            if (rope) { f32x4 t0, t1;
                                t0[0] = v0[0] * cs0[0] - v0[1] * cs0[1]; t0[1] = v0[0] * cs0[1] + v0[1] * cs0[0]; t0[2] = v0[2] * cs0[2] - v0[3] * cs0[3]; t0[3] = v0[2] * cs0[3] + v0[3] * cs0[2];
                                t1[0] = v1[0] * cs1[0] - v1[1] * cs1[1]; t1[1] = v1[0] * cs1[1] + v1[1] * cs1[0]; t1[2] = v1[2] * cs1[2] - v1[3] * cs1[3]; t1[3] = v1[2] * cs1[3] + v1[3] * cs1[2];
                                v0 = t0; v1 = t1; } }
                        u32x4 w; w.x = cvtpk(v0[0], v0[1]); w.y = cvtpk(v0[2], v0[3]); w.z = cvtpk(v1[0], v1[1]); w.w = cvtpk(v1[2], v1[3]);
                        *(u32x4*)(rowp + bj * 128) = w; } }
        } else if (mode == E_BR) {
            const int br = u.br;
            const GAS char* gb_ = (const GAS char*)F_GATES + ((size_t)(u.pm * 256 + wr * 64) * GATEW + br * DM + u.pn * 256 + wc * 32) * 2;
            GAS char* pb_ = (GAS char*)F_GATES + ((size_t)(u.pm * 256 + wr * 64) * GATEW + u.pn * 256 + wc * 32) * 2;
            const unsigned gl_ = (unsigned)(fr * GATEW + 8 * fq) * 2u;
#pragma unroll
            for (int ai = 0; ai < 2; ++ai) {
                u32x4 gw[4][2], pw[4][2];
#pragma unroll
                for (int m = 0; m < 4; ++m)
#pragma unroll
                    for (int bj = 0; bj < 2; ++bj) gw[m][bj] = *(const GAS u32x4*)(gb_ + ((size_t)(ai * 128 + m * 16) * GATEW + bj * 128) * 2 + gl_);
                if (br > 0) {
#pragma unroll
                    for (int m = 0; m < 4; ++m)
#pragma unroll
                        for (int bj = 0; bj < 2; ++bj) pw[m][bj] = *(const GAS u32x4*)(pb_ + ((size_t)(ai * 128 + m * 16) * GATEW + bj * 128) * 2 + gl_);
                } else {
#pragma unroll
                    for (int m = 0; m < 4; ++m)
#pragma unroll
                        for (int bj = 0; bj < 2; ++bj) pw[m][bj] = (u32x4){0u, 0u, 0u, 0u};
                }
#pragma unroll
                for (int m = 0; m < 4; ++m)
#pragma unroll
                    for (int bj = 0; bj < 2; ++bj) { const u32x4 g = gw[m][bj], p = pw[m][bj];
                        const f32x4 g0 = {bf_lo(g.x), bf_hi(g.x), bf_lo(g.y), bf_hi(g.y)}, g1 = {bf_lo(g.z), bf_hi(g.z), bf_lo(g.w), bf_hi(g.w)};
                        const f32x4 p0 = {bf_lo(p.x), bf_hi(p.x), bf_lo(p.y), bf_hi(p.y)}, p1 = {bf_lo(p.z), bf_hi(p.z), bf_lo(p.w), bf_hi(p.w)};
                        const f32x4 v0 = acc[ai][bj][m][0] * g0 + p0, v1 = acc[ai][bj][m][1] * g1 + p1;
                        u32x4 w; w.x = cvtpk(v0[0], v0[1]); w.y = cvtpk(v0[2], v0[3]); w.z = cvtpk(v1[0], v1[1]); w.w = cvtpk(v1[2], v1[3]);
                        *(GAS u32x4*)(pb_ + ((size_t)(ai * 128 + m * 16) * GATEW + bj * 128) * 2 + gl_) = w; }
                asm volatile("" ::: "memory"); }
        } else if (mode == E_WO) {
#pragma unroll
            for (int ai = 0; ai < 2; ++ai) {
                f32x4 xa[4][2][2];
#pragma unroll
                for (int m = 0; m < 4; ++m)
#pragma unroll
                    for (int bj = 0; bj < 2; ++bj) { const float* xp = F_x + (size_t)(rowb + ai * 128 + m * 16) * DM + colb + bj * 128; xa[m][bj][0] = *(const f32x4*)xp; xa[m][bj][1] = *(const f32x4*)(xp + 4); }
#pragma unroll
                for (int m = 0; m < 4; ++m) { const size_t row = (size_t)(rowb + ai * 128 + m * 16); float s = 0.f;
#pragma unroll
                    for (int bj = 0; bj < 2; ++bj) { const int c = colb + bj * 128;
                        const f32x4 v0 = acc[ai][bj][m][0] + xa[m][bj][0], v1 = acc[ai][bj][m][1] + xa[m][bj][1];
                        u32x4 w; w.x = cvtpk(v0[0], v0[1]); w.y = cvtpk(v0[2], v0[3]); w.z = cvtpk(v1[0], v1[1]); w.w = cvtpk(v1[2], v1[3]);
                        *(u32x4*)(F_X1B + row * DM + c) = w;
                        s += (v0[0] * v0[0] + v0[1] * v0[1]) + (v0[2] * v0[2] + v0[3] * v0[3]) + (v1[0] * v1[0] + v1[1] * v1[1]) + (v1[2] * v1[2] + v1[3] * v1[3]); }
                    s = sum_fq(s);
                    if (fq == 0 && !dry) atomicAdd(F_ssq + row, s); }
                asm volatile("" ::: "memory"); }
        } else if (mode == E_FFI) {
            float rr[2][4];
#pragma unroll
            for (int ai = 0; ai < 2; ++ai)
#pragma unroll
                for (int m = 0; m < 4; ++m) rr[ai][m] = F_ssq[rowb + ai * 128 + m * 16];
#pragma unroll
            for (int ai = 0; ai < 2; ++ai)
#pragma unroll
                for (int m = 0; m < 4; ++m) { const size_t row = (size_t)(rowb + ai * 128 + m * 16);
                    const float r = __builtin_amdgcn_rsqf(rr[ai][m] * (1.0f / DM) + EPS);
                    f32x4 o[2];
#pragma unroll
                    for (int n = 0; n < 2; ++n)
#pragma unroll
                        for (int j = 0; j < 4; ++j) { const float gt = acc[ai][0][m][n][j] * r, up = acc[ai][1][m][n][j] * r; o[n][j] = gt * sigmoidf_(gt) * up; }
                    u32x4 w; w.x = cvtpk(o[0][0], o[0][1]); w.y = cvtpk(o[0][2], o[0][3]); w.z = cvtpk(o[1][0], o[1][1]); w.w = cvtpk(o[1][2], o[1][3]);
                    *(u32x4*)(F_ACT + row * DFF + u.pn * 128 + wc * 32 + 8 * fq) = w; }
        } else {
            const float k_ = dry ? 0.f : 1.f;
            const GAS char* xb_ = (const GAS char*)F_X1B + ((size_t)(u.pm * 256 + wr * 64) * DM + u.pn * 256 + wc * 32) * 2;
            const unsigned xl_ = (unsigned)(fr * DM + 8 * fq) * 2u;
            u32x4 xa[2][4][2];
#pragma unroll
            for (int ai = 0; ai < 2; ++ai)
#pragma unroll
                for (int m = 0; m < 4; ++m)
#pragma unroll
                    for (int bj = 0; bj < 2; ++bj) xa[ai][m][bj] = *(const GAS u32x4*)(xb_ + ((size_t)(ai * 128 + m * 16) * DM + bj * 128) * 2 + xl_);
#pragma unroll
            for (int ai = 0; ai < 2; ++ai) {
#pragma unroll
                for (int m = 0; m < 4; ++m)
#pragma unroll
                    for (int bj = 0; bj < 2; ++bj) { float* op = F_out + (size_t)(rowb + ai * 128 + m * 16) * DM + colb + bj * 128; const u32x4 g = xa[ai][m][bj];
                        const f32x4 x0 = {bf_lo(g.x), bf_hi(g.x), bf_lo(g.y), bf_hi(g.y)}, x1 = {bf_lo(g.z), bf_hi(g.z), bf_lo(g.w), bf_hi(g.w)};
                        *(f32x4*)op = acc[ai][bj][m][0] * k_ + x0; *(f32x4*)(op + 4) = acc[ai][bj][m][1] * k_ + x1; }
                asm volatile("" ::: "memory"); }
        }
    }
};

#define XB_TMO      128
#define XB_XCNT(j)  (256  + 64 * (j))
#define XB_XSUB(j)  (1280 + 64 * (j))
#define XB_XGEN(j)  (2304 + 64 * (j))
#define XB_TOP      3328
#define XB_TOPGEN   3392
#define XCD_BAR_WORDS 3456
#define XB_SPIN_CAP (1u << 18)
__device__ __forceinline__ unsigned xb_ld(unsigned* p)              { return __hip_atomic_load(p, __ATOMIC_RELAXED, __HIP_MEMORY_SCOPE_AGENT); }
__device__ __forceinline__ unsigned xb_add(unsigned* p, unsigned v) { return __hip_atomic_fetch_add(p, v, __ATOMIC_RELAXED, __HIP_MEMORY_SCOPE_AGENT); }
__device__ __forceinline__ unsigned xb_xcc_id() { return (unsigned)__builtin_amdgcn_s_getreg((3 << 11) | 20) & 0xFu; }
#define XB_SPIN(cond, bar) do { unsigned _sp = 0; while (cond) { __builtin_amdgcn_s_sleep(1); \
    if ((++_sp & 255u) == 0u) { if (xb_ld(&(bar)[XB_TMO])) break; if (_sp > XB_SPIN_CAP) { atomicAdd(&(bar)[XB_TMO], 1u); break; } } } } while (0)
struct XcdBarrier { unsigned* bar; unsigned x; volatile LAS unsigned* st; };
__device__ __forceinline__ XcdBarrier xcd_barrier_post(unsigned* bar, volatile LAS unsigned* st) {
    XcdBarrier b; b.bar = bar; b.x = xb_xcc_id(); b.st = st;
    if (threadIdx.x == 0) (void)xb_add(&bar[XB_XCNT(b.x)], 1u);
    return b;
}
__device__ __forceinline__ void xcd_barrier_complete(unsigned* bar, unsigned x, unsigned& nloc, unsigned& nx) {
    const unsigned G = gridDim.x * gridDim.y * gridDim.z;
    unsigned sum, cnt, mine, sp = 0u;
    for (;;) {
        sum = 0u; cnt = 0u; mine = 0u;
#pragma unroll
        for (unsigned j = 0; j < 16; ++j) { const unsigned c = xb_ld(&bar[XB_XCNT(j)]); sum += c; cnt += (c > 0u) ? 1u : 0u; mine = (j == x) ? c : mine; }
        if (sum == G) break;
        __builtin_amdgcn_s_sleep(1);
        if ((++sp & 255u) == 0u) { if (xb_ld(&bar[XB_TMO])) break; if (sp > XB_SPIN_CAP) { atomicAdd(&bar[XB_TMO], 1u); break; } }
    }
    nloc = mine > 0u ? mine : 1u; nx = cnt > 0u ? cnt : 1u;
}
__device__ __forceinline__ void xcd_barrier(const XcdBarrier& b) {
    asm volatile("s_waitcnt vmcnt(0)" ::: "memory");
    __syncthreads();
    if (threadIdx.x == 0) {
        unsigned* bar = b.bar;
        __builtin_amdgcn_s_waitcnt(0);
        unsigned nloc = b.st[0], nx = b.st[1];
        if (nloc == 0u) { xcd_barrier_complete(bar, b.x, nloc, nx); b.st[0] = nloc; b.st[1] = nx; }
        const unsigned old = xb_add(&bar[XB_XSUB(b.x)], 1u);
        const unsigned gen = old / nloc;
        if (old + 1u == (gen + 1u) * nloc) {
            __builtin_amdgcn_fence(__ATOMIC_RELEASE, "agent");
            asm volatile("s_waitcnt vmcnt(0)" ::: "memory");
            const unsigned og = xb_add(&bar[XB_TOP], 1u);
            const unsigned tg = og / nx;
            if (og + 1u == (tg + 1u) * nx) xb_add(&bar[XB_TOPGEN], 1u);
            else XB_SPIN(xb_ld(&bar[XB_TOPGEN]) == tg, bar);
            __builtin_amdgcn_fence(__ATOMIC_ACQUIRE, "agent");
            xb_add(&bar[XB_XGEN(b.x)], 1u);
            asm volatile("s_waitcnt vmcnt(0)" ::: "memory");
        } else {
            XB_SPIN(xb_ld(&bar[XB_XGEN(b.x)]) == gen, bar);
            __builtin_amdgcn_fence(__ATOMIC_ACQUIRE, "agent");
            asm volatile("s_waitcnt vmcnt(0)" ::: "memory");
        }
    }
    __syncthreads();
}

struct TJob { const float* src; bf16_t* dst; const float* gain; int N, ldk, k0, n0, drow; };
__device__ __forceinline__ TJob tjob_plain(const float* W, int N, bf16_t* WT, int ldk, int item) { const int nblk = N / 32, kb = item / nblk, nb = item % nblk; return TJob{W, WT, nullptr, N, ldk, 64 * kb, 32 * nb, 32 * nb}; }
constexpr int TJ_IN = (DM / 64) * (INW / 32), TJ_MKV = (DM / 64) * (1024 / 32), TJ_FO = (DFF / 64) * (DM / 32), TJ_N0 = TJ_IN + TJ_MKV + TJ_FO;
constexpr int TJ_A = (256 / 64) * (DM / 32), TJ_B = (768 / 64) * (DM / 32), TJ_C = (512 / 64) * (DM / 32), TJ_O = (DM / 64) * (DM / 32), TJ_FI = (DM / 64) * (2 * DFF / 32);
constexpr int TJ_N1 = TJ_A + TJ_B + TJ_C + TJ_O + TJ_FI;
__device__ __forceinline__ TJob tjob(const Frame& F, int list, int it) {
    if (list == 0) { if (it < TJ_IN) return tjob_plain(F_w_in, INW, F_Win, DM, it); if (it < TJ_IN + TJ_MKV) return tjob_plain(F_w_mem_kv, 1024, F_Wmkv, DM, it - TJ_IN); return tjob_plain(F_w_ffn_out, DM, F_Wfo, DFF, it - TJ_IN - TJ_MKV); }
    int r = it;
    if (r < TJ_A) return tjob_plain(F_w_br_a, DM, F_Wbr + O_A, OALLW, r); r -= TJ_A;
    if (r < TJ_B) return tjob_plain(F_w_br_b, DM, F_Wbr + O_B, OALLW, r); r -= TJ_B;
    if (r < TJ_C) return tjob_plain(F_w_br_c, DM, F_Wbr + O_C, OALLW, r); r -= TJ_C;
    if (r < TJ_O) return tjob_plain(F_w_o, DM, F_Wo, DM, r); r -= TJ_O;
    const int nblk = (2 * DFF) / 32, kb = r / nblk, nb = r % nblk, n0 = 32 * nb; const int isup = n0 >= DFF, h0 = isup ? n0 - DFF : n0;
    return TJob{F_w_ffn_in, F_Wfi, F_g_ffn, 2 * DFF, DM, 64 * kb, n0, 256 * (h0 / 128) + (isup ? 128 : 0) + (h0 % 128)};
}
__device__ __forceinline__ void tjob_load(const TJob& j, float (&v)[32], int lane) {
    const float* p = j.src + (size_t)(j.k0 + (lane >> 5)) * j.N + j.n0 + (lane & 31);
#pragma unroll
    for (int i = 0; i < 32; ++i) v[i] = __builtin_nontemporal_load(&p[(size_t)(2 * i) * j.N]);
}
__device__ __forceinline__ void tjob_store(const TJob& j, const float (&v)[32], LAS float* scr, int lane) {
    if (j.gain) {
#pragma unroll
        for (int i = 0; i < 32; ++i) scr[(2 * i + (lane >> 5)) * 33 + (lane & 31)] = v[i] * j.gain[j.k0 + 2 * i + (lane >> 5)];
    } else {
#pragma unroll
        for (int i = 0; i < 32; ++i) scr[(2 * i + (lane >> 5)) * 33 + (lane & 31)] = v[i];
    }
    LDS_WAIT(); asm volatile("" ::: "memory");
    const int c = lane & 7;
#pragma unroll
    for (int q = 0; q < 4; ++q) { const int n = (lane >> 3) + 8 * q; const LAS float* s = scr + (8 * c) * 33 + n;
        u32x4 o; o.x = cvtpk(s[0 * 33], s[1 * 33]); o.y = cvtpk(s[2 * 33], s[3 * 33]); o.z = cvtpk(s[4 * 33], s[5 * 33]); o.w = cvtpk(s[6 * 33], s[7 * 33]);
        *(u32x4*)(j.dst + (size_t)(j.drow + n) * j.ldk + j.k0 + 8 * c) = o; }
    LDS_WAIT(); asm volatile("" ::: "memory");
}
__device__ __forceinline__ void tjob_run(const Frame& F, int list, int njobs, int gw, int NGW) {
    LAS float* scr = (LAS float*)(F.lds + F.wave * 16384);
    float va[32], vb[32];
    int it = gw; if (it >= njobs) return;
    TJob ja = tjob(F, list, it), jb = ja; tjob_load(ja, va, F.lane);
    for (;;) {
        const bool hb = it + NGW < njobs; if (hb) { jb = tjob(F, list, it + NGW); tjob_load(jb, vb, F.lane); }
        tjob_store(ja, va, scr, F.lane); if (!hb) break; it += NGW;
        const bool ha = it + NGW < njobs; if (ha) { ja = tjob(F, list, it + NGW); tjob_load(ja, va, F.lane); }
        tjob_store(jb, vb, scr, F.lane); if (!ha) break; it += NGW;
    }
}
__device__ __forceinline__ void rms_row_to_bf16(const float* xrow, const float* g, bf16_t* orow, int lane) {
    const f32x4* xr = (const f32x4*)xrow + lane; const f32x4* gr = (const f32x4*)g + lane;
    f32x4 v[8]; float s = 0.f;
#pragma unroll
    for (int j = 0; j < 8; ++j) { v[j] = __builtin_nontemporal_load(&xr[64 * j]); s += (v[j].x * v[j].x + v[j].y * v[j].y) + (v[j].z * v[j].z + v[j].w * v[j].w); }
    const float r = 1.0f / sqrtf(wave_sum(s) * (1.0f / DM) + EPS);
    u32x2* o8 = (u32x2*)orow + lane;
#pragma unroll
    for (int j = 0; j < 8; ++j) { const f32x4 gg = gr[64 * j]; u32x2 w; w.x = cvtpk(v[j].x * r * gg.x, v[j].y * r * gg.y); w.y = cvtpk(v[j].z * r * gg.z, v[j].w * r * gg.w); o8[64 * j] = w; }
}
__device__ __forceinline__ int t5_bucket(int rel) {
    const int nb = 16, max_exact = 8; int ret = rel > 0 ? nb : 0; const int n = rel < 0 ? -rel : rel;
    int large = max_exact + (int)(logf((float)(n > 1 ? n : 1) / (float)max_exact) / logf(1024.0f / 8.0f) * (float)(nb - max_exact));
    large = large < nb - 1 ? large : nb - 1;
    return ret + (n < max_exact ? n : large);
}
__device__ __forceinline__ void p0_convert_late(const Frame& F, int rank, int nrank) {
    tjob_run(F, 1, TJ_N1, rank * 8 + F.wave, nrank * 8);
}
__device__ __forceinline__ void p0_prologue(const Frame& F) {
    const int gw = F.vcu * 8 + F.wave, NGW = F.G * 8;
    tjob_run(F, 0, TJ_N0, gw, NGW);
    for (int m = gw; m < T + TM; m += NGW) {
        if (m < T) rms_row_to_bf16(F_x + (size_t)m * DM, F_g_mix, (m < HB_SPLIT ? F_HB1 + (size_t)m * DM : F_HB2 + (size_t)(m - HB_SPLIT) * DM), F.lane);
        else rms_row_to_bf16(F_mem + (size_t)(m - T) * DM, F_g_mem, F_MEMN + (size_t)(m - T) * DM, F.lane);
    }
    const int gt = (F.vcu * 512 + F.tid), NGT = F.G * 512;
    for (int i = gt; i < 64 * 32; i += NGT) { const int p = i >> 5, fi = i & 31;
        double inv = 1.0; for (int q = 0; q < fi; ++q) inv *= 0.74989420933245582;
        const double ang = (double)p * inv;
        const int kq = (int)(ang * 0.63661977236758134 + 0.5); const double r = ang - (double)kq * 1.5707963267948966, r2 = r * r;
        double sn = 1.0, cs = 1.0;
        for (int q = 10; q >= 1; --q) { sn = 1.0 - sn * r2 / (double)((2 * q) * (2 * q + 1)); cs = 1.0 - cs * r2 / (double)((2 * q - 1) * (2 * q)); }
        sn *= r;
        const int qd = kq & 3; const double c = qd == 0 ? cs : (qd == 1 ? -sn : (qd == 2 ? -cs : sn)), s = qd == 0 ? sn : (qd == 1 ? cs : (qd == 2 ? -sn : -cs));
        F_rope[i] = (f32x2){(float)c, (float)s}; }
    for (int i = gt; i < 6 * 160; i += NGT) { const int hh = i / 160, idx = i % 160; const int g = hh >> 1; const int dil = g == 0 ? 1 : (g == 1 ? 4 : 16);
        float v = 0.f; if (idx <= 128) v = F_rel_bias[t5_bucket((idx - 64) * dil) * 6 + hh] * LOG2E; F_biasT[i] = v; }
}

__device__ __forceinline__ int crow(int r, int hi) { return (r & 3) + 8 * (r >> 2) + 4 * hi; }
namespace attnb {
using s16x4  = __attribute__((ext_vector_type(4))) short;
constexpr int D = 128, NW = 8, QBLK = 32, KVBLK = 64;
constexpr float THRL = 8.f * 1.4426950408889634f;
constexpr int SDEPTH = 2;
constexpr size_t SHM_V = KVBLK * D * 2, SHM_K = KVBLK * D * 2, SHM_ATTN = 2 * SHM_V + 2 * SHM_K + NW * 64 * 4;
#define KSWZ(row, colB) ((row) * 256 + ((colB) ^ (((row) & 7) << 4)))
#define SBAR() __builtin_amdgcn_sched_barrier(0)
__device__ __forceinline__ unsigned cvtpk_a(float lo, float hi) { unsigned r; asm volatile("v_cvt_pk_bf16_f32 %0, %1, %2" : "=v"(r) : "v"(lo), "v"(hi)); return r; }
__device__ __forceinline__ void partialSM(f32x16& p0, f32x16& p1, float& m_reg, float& mn, float& alpha) {
  float pmax = p0[0]; for (int r = 1; r < 16; ++r) pmax = fmaxf(pmax, p0[r]); for (int r = 0; r < 16; ++r) pmax = fmaxf(pmax, p1[r]);
  { auto rr = __builtin_amdgcn_permlane32_swap(__float_as_uint(pmax), __float_as_uint(pmax), false, false);
    pmax = fmaxf(__uint_as_float(rr[0]), __uint_as_float(rr[1])); }
  if (__builtin_expect(__all(pmax - m_reg <= THRL), 1)) { mn = m_reg; alpha = 1.f; }
  else { mn = fmaxf(m_reg, pmax); alpha = __builtin_amdgcn_exp2f(m_reg - mn); m_reg = mn; }
  for (int r = 0; r < 16; ++r) p0[r] = p0[r] - mn; for (int r = 0; r < 16; ++r) p1[r] = p1[r] - mn;
  for (int r = 0; r < 16; ++r) p0[r] = __builtin_amdgcn_exp2f(p0[r]);
}
__device__ __forceinline__ void finishSM(f32x16& p0, f32x16& p1, float alpha, float& l_reg, bf16x8& pa0, bf16x8& pa1, bf16x8& pa2, bf16x8& pa3) {
  for (int r = 0; r < 16; ++r) p1[r] = __builtin_amdgcn_exp2f(p1[r]);
  float ps = 0; for (int r = 0; r < 16; ++r) ps += p0[r]; for (int r = 0; r < 16; ++r) ps += p1[r];
  { auto rr = __builtin_amdgcn_permlane32_swap(__float_as_uint(ps), __float_as_uint(ps), false, false);
    ps = __uint_as_float(rr[0]) + __uint_as_float(rr[1]); }
  l_reg = l_reg * alpha + ps;
#define PK4(P, BASE, OUT) do { unsigned a0 = cvtpk_a(P[BASE + 0], P[BASE + 1]), a1 = cvtpk_a(P[BASE + 2], P[BASE + 3]);   \
    unsigned b0 = cvtpk_a(P[BASE + 4], P[BASE + 5]), b1 = cvtpk_a(P[BASE + 6], P[BASE + 7]);                              \
    auto r0 = __builtin_amdgcn_permlane32_swap(a0, b0, false, false); auto r1 = __builtin_amdgcn_permlane32_swap(a1, b1, false, false); \
    u32x4 w = {r0[0], r1[0], r0[1], r1[1]}; OUT = *reinterpret_cast<bf16x8*>(&w); } while (0)
  PK4(p0, 0, pa0); PK4(p0, 8, pa1); PK4(p1, 0, pa2); PK4(p1, 8, pa3);
#undef PK4
}
__device__ __forceinline__ void qkt(f32x16& p0, f32x16& p1, const bf16_t* Ks, const bf16x8* qr, int r32, int hi) {
  p0 = f32x16{}; p1 = f32x16{};
  for (int d0 = 0; d0 < 8; ++d0) { int cb = (d0 * 16 + hi * 8) * 2;
    bf16x8 b0 = *reinterpret_cast<const bf16x8*>((const char*)Ks + KSWZ(r32, cb));
    bf16x8 b1 = *reinterpret_cast<const bf16x8*>((const char*)Ks + KSWZ(32 + r32, cb));
    p0 = __builtin_amdgcn_mfma_f32_32x32x16_bf16(b0, qr[d0], p0, 0, 0, 0);
    p1 = __builtin_amdgcn_mfma_f32_32x32x16_bf16(b1, qr[d0], p1, 0, 0, 0); }
}
__device__ __forceinline__ int v_st(int k, int c) { const int kk = (k & ~0xC) | ((k & 4) << 1) | ((k & 8) >> 1); return ((kk >> 3) * 4 + (c >> 5)) * 512 + ((kk & 7) * 32 + (c & 31)) * 2; }
__device__ __forceinline__ int v_rd_base(int lane) { return ((lane & 3) << 3) | (((lane >> 2) & 3) << 6) | (((lane >> 4) & 1) << 5) | (((lane >> 5) & 1) << 8); }
constexpr int v_rd_off(int d0, int ks, int half) { return d0 * 512 + ks * 4096 + half * 2048; }
template <int OFF> __device__ __forceinline__ s16x4 tr_read(int vb) {
  s16x4 r; asm volatile("ds_read_b64_tr_b16 %0, %1 offset:%2" : "=&v"(r) : "v"(vb), "i"(OFF) : "memory"); return r;
}
template <int D0> __device__ __forceinline__ void pv_one(f32x16& od, int vb, bf16x8 pa0, bf16x8 pa1, bf16x8 pa2, bf16x8 pa3) {
  const s16x4 l0 = tr_read<v_rd_off(D0, 0, 0)>(vb), h0 = tr_read<v_rd_off(D0, 0, 1)>(vb), l1 = tr_read<v_rd_off(D0, 1, 0)>(vb), h1 = tr_read<v_rd_off(D0, 1, 1)>(vb);
  const s16x4 l2 = tr_read<v_rd_off(D0, 2, 0)>(vb), h2 = tr_read<v_rd_off(D0, 2, 1)>(vb), l3 = tr_read<v_rd_off(D0, 3, 0)>(vb), h3 = tr_read<v_rd_off(D0, 3, 1)>(vb);
  asm volatile("s_waitcnt lgkmcnt(0)" ::: "memory"); SBAR();
#define PK(L, H) (bf16x8){L[0], L[1], L[2], L[3], H[0], H[1], H[2], H[3]}
  od = __builtin_amdgcn_mfma_f32_32x32x16_bf16(pa0, PK(l0, h0), od, 0, 0, 0);
  od = __builtin_amdgcn_mfma_f32_32x32x16_bf16(pa1, PK(l1, h1), od, 0, 0, 0);
  od = __builtin_amdgcn_mfma_f32_32x32x16_bf16(pa2, PK(l2, h2), od, 0, 0, 0);
  od = __builtin_amdgcn_mfma_f32_32x32x16_bf16(pa3, PK(l3, h3), od, 0, 0, 0);
#undef PK
}
__device__ __forceinline__ void pv_d0(f32x16* o, int vb, bf16x8 pa0, bf16x8 pa1, bf16x8 pa2, bf16x8 pa3) {
  pv_one<0>(o[0], vb, pa0, pa1, pa2, pa3); pv_one<1>(o[1], vb, pa0, pa1, pa2, pa3); pv_one<2>(o[2], vb, pa0, pa1, pa2, pa3); pv_one<3>(o[3], vb, pa0, pa1, pa2, pa3);
}
template <int LDQ, int LDK, int LDO>
__device__ __forceinline__ void attn_dense_body(const bf16_t* __restrict__ Qb, const bf16_t* __restrict__ Kh, const bf16_t* __restrict__ Vh,
                                                bf16_t* __restrict__ Ob, int seq, char* lds, const int tid) {
  const int wid = tid >> 6, lane = tid & 63, r32 = lane & 31, hi = lane >> 5;
  bf16_t* V_lds = (bf16_t*)lds; bf16_t* K_lds = (bf16_t*)(lds + 2 * SHM_V);
  float* ws = (float*)(lds + 2 * SHM_V + 2 * SHM_K) + wid * 64; float* li_l = ws; float* al_l = ws + 32;
  float m_reg = -1e30f, l_reg = 0; f32x16 o[4] = {}; bf16x8 qr[8];
  const bf16_t* Qw = Qb + (long)(wid * QBLK + r32) * LDQ + hi * 8;
#pragma unroll
  for (int d0 = 0; d0 < 8; ++d0) qr[d0] = *reinterpret_cast<const bf16x8*>(Qw + d0 * 16);
  const int sr = tid >> 4, sc = (tid & 15) * 8, vst0 = v_st(sr, sc), vst1 = v_st(32 + sr, sc);
  const int vb0 = (int)(uintptr_t)V_lds + v_rd_base(lane);
  struct { bf16x8 vs0, vs1, ks0, ks1; } sr_[SDEPTH];
#define SLOAD(i, k0) do { sr_[i].vs0 = *reinterpret_cast<const bf16x8*>(&Vh[(long)((k0) + sr) * LDK + sc]); sr_[i].vs1 = *reinterpret_cast<const bf16x8*>(&Vh[(long)((k0) + 32 + sr) * LDK + sc]); \
    sr_[i].ks0 = *reinterpret_cast<const bf16x8*>(&Kh[(long)((k0) + sr) * LDK + sc]); sr_[i].ks1 = *reinterpret_cast<const bf16x8*>(&Kh[(long)((k0) + 32 + sr) * LDK + sc]); } while (0)
#define SWRITE(b, i) do { *(bf16x8*)((char*)V_lds + (b) * SHM_V + vst0) = sr_[i].vs0;          \
    *(bf16x8*)((char*)V_lds + (b) * SHM_V + vst1) = sr_[i].vs1; int kc = sc * 2;               \
    *(bf16x8*)((char*)K_lds + (b) * SHM_K + KSWZ(sr, kc)) = sr_[i].ks0;                       \
    *(bf16x8*)((char*)K_lds + (b) * SHM_K + KSWZ(32 + sr, kc)) = sr_[i].ks1; } while (0)
#define SWAIT() do { asm volatile("s_waitcnt vmcnt(4)" ::: "memory"); } while (0)
#define RESC(a) do { if (__any((a) < 1.f)) { if (hi == 0) al_l[r32] = (a); asm volatile("s_waitcnt lgkmcnt(0)" ::: "memory"); \
    for (int d = 0; d < 4; ++d) for (int r = 0; r < 16; ++r) o[d][r] *= al_l[crow(r, hi)]; } } while (0)
  f32x16 pA0, pA1, pB0, pB1; float mnA, mnB, alA, alB; bf16x8 pa0, pa1, pa2, pa3; const int NT = seq / KVBLK;
  constexpr int SE = 0, SO = SDEPTH - 1;
  SLOAD(SE, 0); asm volatile("s_waitcnt vmcnt(0)" ::: "memory"); SWRITE(0, SE); __syncthreads();
  qkt(pA0, pA1, K_lds, qr, r32, hi); partialSM(pA0, pA1, m_reg, mnA, alA);
  SLOAD(SO, KVBLK); if (2 < NT) SLOAD(SE, 2 * KVBLK);
  SWAIT(); SWRITE(1, SO); __syncthreads();
  for (int j = 1; j + 1 < NT; j += 2) {
    SBAR(); qkt(pB0, pB1, (bf16_t*)((char*)K_lds + SHM_K), qr, r32, hi);
    finishSM(pA0, pA1, alA, l_reg, pa0, pa1, pa2, pa3); SBAR();
    SLOAD(SO, (j + SDEPTH) * KVBLK); SBAR();
    pv_d0(o, vb0, pa0, pa1, pa2, pa3); partialSM(pB0, pB1, m_reg, mnB, alB);
    __syncthreads(); SWAIT(); SWRITE(0, SE);
    RESC(alB); __syncthreads();
    SBAR(); qkt(pA0, pA1, K_lds, qr, r32, hi);
    finishSM(pB0, pB1, alB, l_reg, pa0, pa1, pa2, pa3); SBAR();
    if (j + 3 < NT) SLOAD(SE, (j + 1 + SDEPTH) * KVBLK); SBAR();
    pv_d0(o, vb0 + (int)SHM_V, pa0, pa1, pa2, pa3); partialSM(pA0, pA1, m_reg, mnA, alA);
    __syncthreads(); SWAIT(); SWRITE(1, SO);
    RESC(alA); __syncthreads();
  }
  SBAR(); qkt(pB0, pB1, (bf16_t*)((char*)K_lds + SHM_K), qr, r32, hi);
  finishSM(pA0, pA1, alA, l_reg, pa0, pa1, pa2, pa3); SBAR();
  pv_d0(o, vb0, pa0, pa1, pa2, pa3); partialSM(pB0, pB1, m_reg, mnB, alB);
  __syncthreads(); RESC(alB);
  finishSM(pB0, pB1, alB, l_reg, pa0, pa1, pa2, pa3); SBAR();
  pv_d0(o, vb0 + (int)SHM_V, pa0, pa1, pa2, pa3);
  if (hi == 0) li_l[r32] = l_reg; asm volatile("s_waitcnt lgkmcnt(0)" ::: "memory");
  float rli[16];
#pragma unroll
  for (int r = 0; r < 16; ++r) rli[r] = __builtin_amdgcn_rcpf(li_l[crow(r, hi)]);
  GAS bf16_t* Ow = (GAS bf16_t*)(Ob + (long)(wid * QBLK + 4 * hi) * LDO + r32);
  asm volatile("" : "+v"(Ow));
#pragma unroll
  for (int r = 0; r < 16; ++r) { GAS bf16_t* rowp = Ow + (long)((r & 3) + 8 * (r >> 2)) * LDO;
    for (int d0 = 0; d0 < 4; ++d0) rowp[d0 * 32] = (bf16_t)(cvtpk(o[d0][r] * rli[r], 0.f) & 0xffffu); }
#undef SLOAD
#undef SWRITE
#undef SWAIT
#undef RESC
}
#undef KSWZ
#undef SBAR
}

__device__ __forceinline__ void attn_b_unit(const Frame& F, int b, int h, int qb) {
    const bf16_t* Q = F_QKV + (size_t)(b * SEQ + qb * 256) * QKVW + C_QB + h * HD;
    const bf16_t* K = F_QKV + (size_t)(b * SEQ) * QKVW + C_KB + (h / 3) * HD;
    bf16_t* O = F_OALL + (size_t)(b * SEQ + qb * 256) * OALLW + O_B + h * HD;
    int t_ = F.tid; asm volatile("" : "+v"(t_));
    attnb::attn_dense_body<QKVW, QKVW, OALLW>(Q, K, K + (C_VB - C_KB), O, SEQ, (char*)F.lds, t_);
}
__device__ __forceinline__ void attn_c_unit(const Frame& F, int b, int h, int qb) {
    const bf16_t* Q = F_QKV + (size_t)(b * SEQ + qb * 256) * QKVW + C_QC + h * HD;
    const bf16_t* K = F_MKV + (size_t)(b * NMEM) * 1024 + h * HD;
    bf16_t* O = F_OALL + (size_t)(b * SEQ + qb * 256) * OALLW + O_C + h * HD;
    int t_ = F.tid; asm volatile("" : "+v"(t_));
    attnb::attn_dense_body<QKVW, 1024, OALLW>(Q, K, K + 512, O, NMEM, (char*)F.lds, t_);
}
typedef short v4i16_t __attribute__((ext_vector_type(4)));
__device__ __forceinline__ void attn_item_a(const Frame& F, int item, int lane, LAS unsigned char* vl) {
    const int r32 = lane & 31, hi = lane >> 5;
    const int hh = item / 512, idx = item % 512, g = hh >> 1; const int dil = g == 0 ? 1 : (g == 1 ? 4 : 16); const int L = SEQ / dil, nqb = L / 32;
    const int n = idx / nqb, qb = idx % nqb, b = n / dil, rr = n % dil;
    const int tok0 = b * SEQ + rr, q0 = qb * 32, tile0 = q0 - 64;
    const bf16_t* base = F_QKV;
    const int qtok = tok0 + (q0 + r32) * dil;
    const bf16_t* qp = base + (size_t)qtok * QKVW + C_QA + hh * HD + 8 * hi;
    bf16x8 qf[8], kfA[8]; u32x4 vr[8];
#define A_LOADK(KF, pos0_) do { int kp_ = (pos0_) + r32; kp_ = kp_ < 0 ? 0 : (kp_ >= L ? L - 1 : kp_); const bf16_t* kptr_ = base + (size_t)(tok0 + kp_ * dil) * QKVW + C_KA + hh * HD + 8 * hi; \
        _Pragma("unroll") for (int s = 0; s < 8; ++s) KF[s] = *(const bf16x8*)(kptr_ + 16 * s); } while (0)
#define A_LOADV(VR, pos0_) do { _Pragma("unroll") for (int i = 0; i < 8; ++i) { int kp_ = (pos0_) + 4 * i + (lane >> 4); kp_ = kp_ < 0 ? 0 : (kp_ >= L ? L - 1 : kp_); \
        VR[i] = *(const u32x4*)(base + (size_t)(tok0 + kp_ * dil) * QKVW + C_VA + hh * HD + 8 * (lane & 15)); } } while (0)
    A_LOADK(kfA, tile0); A_LOADV(vr, tile0);
#pragma unroll
    for (int s = 0; s < 8; ++s) qf[s] = *(const bf16x8*)(qp + 16 * s);
    LAS float* bl = (LAS float*)(vl + 8704);
    { const float* bT = F_biasT + hh * 160; for (int i = lane; i < 160; i += 64) bl[i] = bT[i]; }
    f32x16 o[4];
#pragma unroll
    for (int d = 0; d < 4; ++d)
#pragma unroll
        for (int r = 0; r < 16; ++r) o[d][r] = 0.f;
    float mrun = -1e30f, lrun = 0.f;
    LAS unsigned char* vwr = vl + (lane >> 4) * 272 + (lane & 15) * 16;
    LAS unsigned char* vrd = vl + (4 * hi + ((lane & 15) >> 2)) * 272 + (16 * ((lane >> 4) & 1) + 4 * (lane & 3)) * 2;
#pragma unroll 1
    for (int j = 0; j < 5; ++j) {
        const int pos0 = tile0 + 32 * j;
#pragma unroll
        for (int i = 0; i < 8; ++i) *(LAS u32x4*)(vwr + i * 4 * 272) = vr[i];
        if (j + 1 < 5) { A_LOADV(vr, pos0 + 32); }
        f32x16 p;
#pragma unroll
        for (int r = 0; r < 16; ++r) p[r] = 0.f;
#pragma unroll
        for (int s = 0; s < 8; ++s) p = __builtin_amdgcn_mfma_f32_32x32x16_bf16(kfA[s], qf[s], p, 0, 0, 0);
        if (j + 1 < 5) { A_LOADK(kfA, pos0 + 32); }
        bool valid[16]; float tmax = -1e30f;
#pragma unroll
        for (int r = 0; r < 16; ++r) { const int kk = pos0 + crow(r, hi), rel = kk - (q0 + r32); valid[r] = (kk >= 0) && (kk < L) && (rel >= -64) && (rel <= 64);
            const int bi = rel < -64 ? 0 : (rel > 64 ? 128 : rel + 64); p[r] += bl[bi]; if (valid[r]) tmax = fmaxf(tmax, p[r]); }
        tmax = fmaxf(tmax, __shfl_xor(tmax, 32));
        const float mnew = fmaxf(mrun, tmax), alpha = __builtin_amdgcn_exp2f(mrun - mnew);
        float rs = 0.f;
#pragma unroll
        for (int r = 0; r < 16; ++r) { const float e_ = valid[r] ? __builtin_amdgcn_exp2f(p[r] - mnew) : 0.f; p[r] = e_; rs += e_; }
        rs += __shfl_xor(rs, 32);
        lrun = lrun * alpha + rs; mrun = mnew;
#pragma unroll
        for (int d = 0; d < 4; ++d)
#pragma unroll
            for (int r = 0; r < 16; ++r) o[d][r] *= alpha;
        unsigned pw[8];
#pragma unroll
        for (int i = 0; i < 8; ++i) pw[i] = cvtpk(p[2 * i], p[2 * i + 1]);
#pragma unroll
        for (int s = 0; s < 2; ++s) {
            const bf16x8 pb = __builtin_bit_cast(bf16x8, (u32x4){pw[4 * s], pw[4 * s + 1], pw[4 * s + 2], pw[4 * s + 3]});
#pragma unroll
            for (int d = 0; d < 4; ++d) {
                const v4i16_t lo = __builtin_amdgcn_ds_read_tr16_b64_v4i16((LAS v4i16_t*)(vrd + (16 * s) * 272 + d * 64));
                const v4i16_t hv = __builtin_amdgcn_ds_read_tr16_b64_v4i16((LAS v4i16_t*)(vrd + (16 * s + 8) * 272 + d * 64));
                const bf16x8 vf = {lo[0], lo[1], lo[2], lo[3], hv[0], hv[1], hv[2], hv[3]};
                o[d] = __builtin_amdgcn_mfma_f32_32x32x16_bf16(vf, pb, o[d], 0, 0, 0); }
        }
    }
#undef A_LOADK
#undef A_LOADV
    const float inv = 1.0f / lrun;
    bf16_t* op = F_OG + (size_t)qtok * 768 + hh * HD;
#pragma unroll
    for (int d = 0; d < 4; ++d)
#pragma unroll
        for (int r = 0; r < 16; r += 2) { const int dd = 32 * d + crow(r, hi); *(unsigned*)(op + dd) = cvtpk(o[d][r] * inv, o[d][r + 1] * inv); }
    if (hi == 0) F_lse[(size_t)qtok * 6 + hh] = mrun + __builtin_amdgcn_logf(lrun);
}
__device__ __forceinline__ void attn_a_chunk(const Frame& F, int ch) {
    const int b = ch >> 4, s = (ch >> 3) & 1, c8 = ch & 7;
    int ln_ = F.lane; asm volatile("" : "+v"(ln_));
    LAS unsigned char* vl = F.lds + F.wave * 16384;
    for (int j = F.wave; j < 48; j += 8) { const int g = j >> 4, k = j & 15, hh = 2 * g + s;
        int idx;
        if (g == 0) idx = b * 128 + 16 * c8 + k; else if (g == 1) idx = (b * 4 + (k >> 2)) * 32 + 4 * c8 + (k & 3); else idx = (b * 16 + k) * 8 + c8;
        attn_item_a(F, hh * 512 + idx, ln_, vl); }
    VM_WAIT(); __syncthreads();
    if (F.tid == 0) { __builtin_amdgcn_fence(__ATOMIC_ACQUIRE, "agent"); VM_WAIT(); }
    __syncthreads();
    const int lane = ln_;
    const int tb = b * SEQ + 512 * c8 + F.wave;
    float w0, w1, w2;
    { const size_t t = (size_t)(tb + 8 * lane); const float l0 = F_lse[t * 6 + s], l1 = F_lse[t * 6 + 2 + s], l2 = F_lse[t * 6 + 4 + s];
      const float mx = fmaxf(l0, fmaxf(l1, l2)); w0 = __builtin_amdgcn_exp2f(l0 - mx); w1 = __builtin_amdgcn_exp2f(l1 - mx); w2 = __builtin_amdgcn_exp2f(l2 - mx);
      const float inv = 1.0f / (w0 + w1 + w2); w0 *= inv; w1 *= inv; w2 *= inv; }
    for (int j0 = 0; j0 < 64; j0 += 8) {
        unsigned ra[8], rb[8], rc[8];
#pragma unroll
        for (int q = 0; q < 8; ++q) { const bf16_t* og = F_OG + (size_t)(tb + 8 * (j0 + q)) * 768 + s * HD; ra[q] = ((const unsigned*)og)[lane]; rb[q] = ((const unsigned*)(og + 256))[lane]; rc[q] = ((const unsigned*)(og + 512))[lane]; }
#pragma unroll
        for (int q = 0; q < 8; ++q) { const int j = j0 + q;
            const float a0 = __builtin_bit_cast(float, __builtin_amdgcn_readlane(__builtin_bit_cast(int, w0), j)), a1 = __builtin_bit_cast(float, __builtin_amdgcn_readlane(__builtin_bit_cast(int, w1), j)),
                        a2 = __builtin_bit_cast(float, __builtin_amdgcn_readlane(__builtin_bit_cast(int, w2), j));
            ((unsigned*)(F_OALL + (size_t)(tb + 8 * j) * OALLW + O_A + s * HD))[lane] =
                cvtpk(a0 * bf_lo(ra[q]) + a1 * bf_lo(rb[q]) + a2 * bf_lo(rc[q]), a0 * bf_hi(ra[q]) + a1 * bf_hi(rb[q]) + a2 * bf_hi(rc[q])); }
    }
    __syncthreads();
}
__device__ __forceinline__ void p2_attention(const Frame& F) {
    constexpr int NBI = NB * 6 * 16, NCI = NB * 4 * 16, NCH = 64;
    int u0, ustep, nu, bh0 = -1, c0 = 0, cstep = 1, nc = 0, a0 = 0, astep = 1, na = 0, fw = -1, fn = 1;
    if (F.G == 256) { const int xg = F.vcu >> 5, li = F.vcu & 31; bh0 = xg;
        if (li < 24) { u0 = 2 * li; ustep = 1; nu = 2; }
        else { u0 = 0; ustep = 1; nu = 0; const int i = li - 24, lc = xg * 8 + i; c0 = 4 * lc; nc = 4; a0 = (xg >> 1) * 16 + (xg & 1) * 8 + i; na = 1; fw = lc * 8 + F.wave; fn = 512; } }
    else { u0 = F.vcu; ustep = F.G; nu = (NBI - F.vcu + F.G - 1) / F.G; if (nu < 0) nu = 0; c0 = F.vcu; cstep = F.G; nc = (NCI - F.vcu + F.G - 1) / F.G; if (nc < 0) nc = 0;
        a0 = F.vcu; astep = F.G; na = (NCH - F.vcu + F.G - 1) / F.G; if (na < 0) na = 0; fw = F.vcu * 8 + F.wave; fn = F.G * 8; }
    for (int k = 0; k < nu; ++k) { const int u = u0 + k * ustep; int b, h, qb;
        if (bh0 >= 0) { b = bh0 >> 1; h = (bh0 & 1) * 3 + (u >> 4); qb = u & 15; } else { const int bh = u >> 4; b = bh / 6; h = bh % 6; qb = u & 15; }
        attn_b_unit(F, b, h, qb); }
    for (int k = 0; k < nc; ++k) { const int c = c0 + k * cstep, bh = c >> 4; attn_c_unit(F, bh >> 2, bh & 3, c & 15); }
    __syncthreads();
    for (int k = 0; k < na; ++k) attn_a_chunk(F, a0 + k * astep);
}


enum Phase { PH_PRO = 0, PH_PROJ, PH_ATTN, PH_BR, PH_WO, PH_FFI, PH_FFO, PH_COUNT };

__global__ void __launch_bounds__(512, 2) mk_fwd(Args args) {
    extern __shared__ __attribute__((aligned(16))) unsigned char lds_raw[];
    Frame F0;
    F0.lds = (LAS unsigned char*)lds_raw;
    F0.tid = threadIdx.x; F0.lane = F0.tid & 63; F0.wave = __builtin_amdgcn_readfirstlane(F0.tid >> 6);
    F0.G = gridDim.x; { const int bx = blockIdx.x; F0.vcu = (F0.G % 8 == 0) ? (bx % 8) * (F0.G / 8) + bx / 8 : bx; }
    F0.a = (const __attribute__((address_space(4))) Args*)__builtin_amdgcn_kernarg_segment_ptr(); F0.ws = (GAS unsigned char*)args.ws; F0.out = (GAS float*)args.out;

    for (int u = F0.tid; u < (LDS_BYTES - LDSCTL_OFF) / 4; u += 512) ((LAS unsigned*)(F0.lds + LDSCTL_OFF))[u] = 0u;
    __syncthreads();
    const int lo = args.ph_lo, hi = args.ph_hi;
    const bool use_bar = (hi - lo) > 1;
    XcdBarrier bar; bar.bar = ((unsigned*)(GAS unsigned*)(F0.ws + WS_CTL)) + CW_BAR; bar.x = 0; bar.st = (volatile LAS unsigned*)(F0.lds + LDSCTL_OFF + 64);
    if (use_bar) bar = xcd_barrier_post(((unsigned*)(GAS unsigned*)(F0.ws + WS_CTL)) + CW_BAR, (volatile LAS unsigned*)(F0.lds + LDSCTL_OFF + 64));

    for (int ph2 = lo * 2; ph2 < hi * 2; ++ph2) {
        const int ph = ph2 >> 1; if ((ph2 & 1) && ph != PROBE_DUP) continue;
        if (ph2 != lo * 2) xcd_barrier(bar);
        Frame F = F0;
        { int wv_ = F0.wave; asm volatile("" : "+s"(wv_)); int ln_ = (int)__builtin_amdgcn_mbcnt_hi(~0u, __builtin_amdgcn_mbcnt_lo(~0u, 0u)); asm volatile("" : "+v"(ln_));
          F.wave = wv_; F.lane = ln_; F.tid = wv_ * 64 + ln_; }
        { GAS unsigned char* w_ = F0.ws; GAS float* o_ = F0.out; int g_ = F0.G, v_ = F0.vcu; const __attribute__((address_space(4))) Args* a_ = F0.a; asm volatile("" : "+s"(w_), "+s"(o_), "+s"(g_), "+s"(v_), "+s"(a_)); F.ws = w_; F.out = o_; F.G = g_; F.vcu = v_; F.a = a_; }
        if (ph == PH_PRO) {
            p0_prologue(F);
        } else if (ph == PH_ATTN) {
            p2_attention(F);
        } else {
            const int ncall = (ph == PH_PROJ) ? 2 : 1;
            for (int c = 0; c < ncall; ++c) {
                pg8::Gemm g; int mode;
                if (ph == PH_PROJ) { if (c == 0) { g = pg8::Gemm{F_HB1, F_Win, DM, DM, T, INW, DM, F_HB2, HB_SPLIT / 256, 1}; mode = E_PROJ; } else { g = pg8::Gemm{F_MEMN, F_Wmkv, DM, DM, TM, 1024, DM, nullptr, 1 << 20, 1}; mode = E_MKV; } }
                else if (ph == PH_BR) { g = pg8::Gemm{F_OALL, F_Wbr, OALLW, OALLW, T, DM, OALLW, nullptr, 1 << 20, 3}; mode = E_BR; }
                else if (ph == PH_WO) { g = pg8::Gemm{F_GATES, F_Wo, GATEW, DM, T, DM, DM, nullptr, 1 << 20, 1}; mode = E_WO; }
                else if (ph == PH_FFI) { g = pg8::Gemm{F_X1B, F_Wfi, DM, DM, T, 2 * DFF, DM, nullptr, 1 << 20, 1}; mode = E_FFI; }
                else { g = pg8::Gemm{F_ACT, F_Wfo, DFF, DFF, T, DM, DFF, nullptr, 1 << 20, 1}; mode = E_FFO; }
                pg8::StaticOrder S; S.init(g.M, g.N, F.G, (int)blockIdx.x, (g.N > 4096) ? WGM_BIG : WGM_SMALL); S.nbr = g.nbr;
                EpiRT E{mode, &F, (PROBE_DUP == ph) && !(ph2 & 1)};
                pg8::gemm_phase<EpiRT>(F.lds, g, S, E, F.tid);
            }
            if (ph == PH_PROJ) { const int nmem = F.G > 16 ? 16 : 0;
                if ((int)blockIdx.x >= nmem) p0_convert_late(F, (int)blockIdx.x - nmem, F.G - nmem); }
        }
    }
}

extern "C" void kernel_launch(void* const* d_in, const int* in_sizes, int n_in, void* d_out, int out_size, void* d_ws, size_t ws_size, hipStream_t stream) {
    static int grid = 0;
    if (grid == 0) {
        if (n_in != 20 || in_sizes[0] != T * DM || out_size != T * DM || ws_size < WS_END) { fprintf(stderr, "kernel_launch: unexpected shapes (n_in %d in0 %d out %d ws %zu)\n", n_in, n_in > 0 ? in_sizes[0] : -1, out_size, ws_size); grid = -1; return; }
        int dev = 0, cus = 0, per_cu = 0;
        if (hipGetDevice(&dev) != hipSuccess || hipDeviceGetAttribute(&cus, hipDeviceAttributeMultiprocessorCount, dev) != hipSuccess) { grid = -1; return; }
        if (hipFuncSetAttribute((const void*)mk_fwd, hipFuncAttributeMaxDynamicSharedMemorySize, LDS_BYTES) != hipSuccess) { fprintf(stderr, "kernel_launch: hipFuncSetAttribute failed\n"); grid = -1; return; }
        if (hipOccupancyMaxActiveBlocksPerMultiprocessor(&per_cu, (const void*)mk_fwd, 512, LDS_BYTES) != hipSuccess || per_cu < 1) { fprintf(stderr, "kernel_launch: occupancy query says %d blocks per CU\n", per_cu); (void)hipGetLastError(); grid = -1; return; }
        grid = cus;
    }
    if (grid < 0) return;
    (void)hipMemsetAsync((char*)d_ws + WS_CTL, 0, CTL_ZERO_BYTES, stream);
    Args a{};
    for (int i = 0; i < 20; ++i) a.in[i] = (const float*)d_in[i];
    a.out = (float*)d_out; a.ws = (unsigned char*)d_ws;
    if (MK_N_LAUNCHES == 1) { a.ph_lo = 0; a.ph_hi = PH_COUNT; hipLaunchKernelGGL(mk_fwd, dim3(grid), dim3(512), LDS_BYTES, stream, a); }
    else for (int ph = 0; ph < PH_COUNT; ++ph) { a.ph_lo = ph; a.ph_hi = ph + 1; hipLaunchKernelGGL(mk_fwd, dim3(grid), dim3(512), LDS_BYTES, stream, a); }
}
```

```cpp
#include <hip/hip_runtime.h>
#include <cstdio>
#include <cstdint>

#ifndef MK_N_LAUNCHES
#define MK_N_LAUNCHES 1
#endif

#ifndef WGM_BIG
#define WGM_BIG 2
#endif
#ifndef WGM_SMALL
#define WGM_SMALL 2
#endif
#ifndef PROBE_DUP
#define PROBE_DUP -1
#endif
#define LAS __attribute__((address_space(3)))
#define GAS __attribute__((address_space(1)))
typedef unsigned short bf16_t;
typedef short bf16x8 __attribute__((ext_vector_type(8)));
typedef float f32x4 __attribute__((ext_vector_type(4)));
typedef float f32x2 __attribute__((ext_vector_type(2)));
typedef float f32x16 __attribute__((ext_vector_type(16)));
typedef unsigned u32x4 __attribute__((ext_vector_type(4)));
typedef unsigned u32x2 __attribute__((ext_vector_type(2)));
typedef __bf16 bf16x2_t __attribute__((ext_vector_type(2)));

constexpr int NB = 4, SEQ = 4096, DM = 2048, T = NB * SEQ, HD = 128, NMEM = 256, TM = NB * NMEM;
constexpr int INW = 10240, QKVW = 4096, GATEW = 6144, DFF = 5632;
constexpr int OALLW = 1536, O_A = 0, O_B = 256, O_C = 1024;
constexpr int C_QA = 0, C_KA = 768, C_VA = 1536, C_QB = 2304, C_KB = 3072, C_VB = 3328, C_QC = 3584;
constexpr float EPS = 1e-6f;
constexpr float LOG2E = 1.4426950408889634f;
constexpr float QSCALE = 0.08838834764831845f * LOG2E;

constexpr size_t MiB = 1u << 20;
constexpr size_t WS_CTL = 0, CTL_ZERO_BYTES = 128 * 1024;
constexpr size_t WS_SSQ = 64 * 1024;
constexpr size_t WS_ROPE = 1 * MiB;
constexpr size_t WS_BIAS = 1 * MiB + 65536;
constexpr size_t WS_LSE = 2 * MiB;
constexpr size_t WS_WIN = 4 * MiB;
constexpr size_t WS_WMKV = 44 * MiB;
constexpr size_t WS_WBR = 48 * MiB;
constexpr size_t WS_WO = 54 * MiB;
constexpr size_t WS_WFO = 62 * MiB;
constexpr size_t WS_WFI = 452 * MiB;
constexpr size_t WS_QKV = 84 * MiB;
constexpr size_t WS_GATES = 212 * MiB;
constexpr size_t WS_OALL = 404 * MiB;
constexpr size_t WS_END = 496 * MiB;
constexpr size_t DO_HB = 0;
constexpr size_t DO_OG = 64 * MiB;
constexpr size_t DO_MEMN = 88 * MiB;
constexpr size_t DO_MKV = 92 * MiB;
constexpr int CW_BAR = 4096;

__device__ __forceinline__ unsigned cvtpk(float lo, float hi) { f32x2 v = {lo, hi}; bf16x2_t b = __builtin_convertvector(v, bf16x2_t); return __builtin_bit_cast(unsigned, b); }
__device__ __forceinline__ float bf_lo(unsigned w) { return __builtin_bit_cast(float, w << 16); }
__device__ __forceinline__ float bf_hi(unsigned w) { return __builtin_bit_cast(float, w & 0xffff0000u); }
__device__ __forceinline__ float bf2f(bf16_t h) { return __builtin_bit_cast(float, (unsigned)h << 16); }
__device__ __forceinline__ float wave_sum(float v) {
#pragma unroll
    for (int o = 1; o < 64; o <<= 1) v += __shfl_xor(v, o);
    return v;
}
#define LDS_WAIT() asm volatile("s_waitcnt lgkmcnt(0)" ::: "memory")
#define VM_WAIT() asm volatile("s_waitcnt vmcnt(0)" ::: "memory")

struct Args { const float* in[20]; float* out; unsigned char* ws; int ph_lo, ph_hi; };
struct Frame {
    LAS unsigned char* lds;
    const __attribute__((address_space(4))) Args* a;
    GAS unsigned char* ws; GAS float* out;
    int tid, lane, wave, vcu, G;
};
#define F_x         ((const float*)(const GAS float*)F.a->in[0])
#define F_mem       ((const float*)(const GAS float*)F.a->in[1])
#define F_rel_bias  ((const float*)(const GAS float*)F.a->in[2])
#define F_g_mix     ((const float*)(const GAS float*)F.a->in[3])
#define F_w_in      ((const float*)(const GAS float*)F.a->in[4])
#define F_g_qa      ((const float*)(const GAS float*)F.a->in[5])
#define F_g_ka      ((const float*)(const GAS float*)F.a->in[6])
#define F_g_qb      ((const float*)(const GAS float*)F.a->in[7])
#define F_g_kb      ((const float*)(const GAS float*)F.a->in[8])
#define F_g_mem     ((const float*)(const GAS float*)F.a->in[9])
#define F_w_mem_kv  ((const float*)(const GAS float*)F.a->in[10])
#define F_g_qc      ((const float*)(const GAS float*)F.a->in[11])
#define F_g_kc      ((const float*)(const GAS float*)F.a->in[12])
#define F_w_br_a    ((const float*)(const GAS float*)F.a->in[13])
#define F_w_br_b    ((const float*)(const GAS float*)F.a->in[14])
#define F_w_br_c    ((const float*)(const GAS float*)F.a->in[15])
#define F_w_o       ((const float*)(const GAS float*)F.a->in[16])
#define F_g_ffn     ((const float*)(const GAS float*)F.a->in[17])
#define F_w_ffn_in  ((const float*)(const GAS float*)F.a->in[18])
#define F_w_ffn_out ((const float*)(const GAS float*)F.a->in[19])
#define F_ctl   ((unsigned*)(GAS unsigned*)(F.ws + WS_CTL))
#define F_ssq   ((float*)(GAS float*)(F.ws + WS_SSQ))
#define F_rx    ((float*)(GAS float*)(F.ws + WS_CTL + 655360))
#define F_rope  ((f32x2*)(GAS f32x2*)(F.ws + WS_ROPE))
#define F_biasT ((float*)(GAS float*)(F.ws + WS_BIAS))
#define F_lse   ((float*)(GAS float*)(F.ws + WS_LSE))
#define F_Win   ((bf16_t*)(GAS bf16_t*)(F.ws + WS_WIN))
#define F_Wmkv  ((bf16_t*)(GAS bf16_t*)(F.ws + WS_WMKV))
#define F_Wbr   ((bf16_t*)(GAS bf16_t*)(F.ws + WS_WBR))
#define F_Wo    ((bf16_t*)(GAS bf16_t*)(F.ws + WS_WO))
#define F_Wfo   ((bf16_t*)(GAS bf16_t*)(F.ws + WS_WFO))
#define F_Wfi   ((bf16_t*)(GAS bf16_t*)(F.ws + WS_WFI))
#define F_QKV   ((bf16_t*)(GAS bf16_t*)(F.ws + WS_QKV))
#define F_GATES ((bf16_t*)(GAS bf16_t*)(F.ws + WS_GATES))
#define F_OALL  ((bf16_t*)(GAS bf16_t*)(F.ws + WS_OALL))
#define F_OG    ((bf16_t*)(GAS bf16_t*)((GAS unsigned char*)F.out + DO_OG))
#define F_HB1   ((bf16_t*)(GAS bf16_t*)((GAS unsigned char*)F.out + DO_HB))
#define F_HB2   F_HB1
#define HB_SPLIT 16384
#define F_MEMN  ((bf16_t*)(GAS bf16_t*)((GAS unsigned char*)F.out + DO_MEMN))
#define F_MKV   ((bf16_t*)(GAS bf16_t*)((GAS unsigned char*)F.out + DO_MKV))
#define F_X1B   ((bf16_t*)(GAS bf16_t*)(F.ws + WS_QKV))
#define F_ACT   ((bf16_t*)(GAS bf16_t*)(F.ws + WS_GATES))
#define F_out   ((float*)F.out)

namespace pg8 {
constexpr int BM = 256, BK = 64, HALF = 128, HTB = HALF * BK * 2, STAGE_BYTES = 8 * HTB, NXCD = 8;
__host__ __device__ __forceinline__ int lds_byte(int r, int c) { const int st = (r >> 4) * 2 + (c >> 5), rr = r & 15, cc = c & 31, ob = rr * 64 + cc * 2; return st * 1024 + (ob ^ (((ob >> 9) & 1) << 5)); }
__host__ __device__ __forceinline__ void stage_rc(int b, int& R, int& C) { const int st = b / 1024, sb = b % 1024, swz = sb ^ (((sb >> 9) & 1) << 5); R = (st >> 1) * 16 + swz / 64; C = (st & 1) * 32 + (swz % 64) / 2; }
__host__ __device__ __forceinline__ int perm32(int rho) { const int n = rho >> 4, i = rho & 15; return 8 * (i >> 2) + 4 * n + (i & 3); }

struct Unit { int pm, pn; };
struct Gemm { const bf16_t* A; const bf16_t* Bt; int lda, ldb, M, N, K; const bf16_t* A2; int pm_split; };
struct StaticOrder {
    int nM, nN, nwg, G, c, WGM, extra;
    __device__ void init(int M, int N, int G_, int c_, int wgm_) { nM = M / BM; nN = N / BM; nwg = nM * nN; G = G_; c = c_; WGM = wgm_; extra = 0; }
    __device__ bool next(int i, Unit& u) const {
        const long L = (long)i * G + c;
        if (L >= nwg) { const long k = L - nwg; if (k >= extra) return false; u.pm = nM + (int)(k >> 2); u.pn = nN + (int)(k & 3); return true; }
        int wgid = (int)L; { const int q = nwg / NXCD, r = nwg % NXCD, xcd = wgid % NXCD, off = wgid / NXCD; wgid = (xcd < r ? xcd * (q + 1) : r * (q + 1) + (xcd - r) * q) + off; }
        const int nig = WGM * nN, gid = wgid / nig, fm = gid * WGM, gsz = (nM - fm) < WGM ? (nM - fm) : WGM;
        u.pm = fm + ((wgid % nig) % gsz); u.pn = (wgid % nig) / gsz; return true;
    }
};

template <class Epi>
__device__ __forceinline__ void gemm_phase(LAS unsigned char* lds, const Gemm g, const StaticOrder& S, const Epi& E, const int tid) {
    const int wid = __builtin_amdgcn_readfirstlane(tid >> 6), lane = tid & 63, wr = wid >> 2, wc = wid & 3, fr = lane & 15, fq = lane >> 4;
    const int K = g.K, nt = K / BK;
    unsigned voffA, voffB;
    { int R, C; stage_rc(tid * 16, R, C); const int Rb = (R & ~31) + perm32(R & 31); voffA = (unsigned)(R * g.lda + C) * 2u; voffB = (unsigned)(Rb * g.ldb + C) * 2u; }
    const size_t rstep_voffA = (size_t)64 * g.lda * 2, rstep_voffB = (size_t)64 * g.ldb * 2;
    const size_t kstep = (size_t)(BK * 2);
    const size_t hstepA = (size_t)HALF * g.lda * 2, hstepB = (size_t)HALF * g.ldb * 2;
    const size_t tstepA = 2 * hstepA, tstepB = 2 * hstepB;
    const unsigned ldsw = (unsigned)wid * 1024u;
    const int aoff = lds_byte(wr * 64 + fr, fq * 8), boff = lds_byte(wc * 32 + fr, fq * 8);
#define PG8_SA(b, h) (((b) * 2 + (h)) * HTB)
#define PG8_SB(b, h) ((4 + (b) * 2 + (h)) * HTB)
#define PG8_STAGE_(bufoff, gbase, voff, rstep) do { _Pragma("unroll") for (int _i = 0; _i < 2; ++_i) \
        __builtin_amdgcn_global_load_lds((const unsigned*)((const char*)(gbase) + (size_t)_i * (rstep) + (voff)), (LAS unsigned*)(lds + (bufoff) + ldsw + _i * 8192), 16, 0, 0); } while (0)
#define PG8_STAGE(bufoff, gbase, voff) PG8_STAGE_(bufoff, gbase, voff, rstep_##voff)
#define PG8_LDA(dst, b, h) do { _Pragma("unroll") for (int m = 0; m < 4; ++m) _Pragma("unroll") for (int k = 0; k < 2; ++k) dst[m][k] = *(const LAS bf16x8*)(lds + PG8_SA(b, h) + aoff + m * 2048 + k * 1024); } while (0)
#define PG8_LDB(dst, b, h) do { _Pragma("unroll") for (int n = 0; n < 2; ++n) _Pragma("unroll") for (int k = 0; k < 2; ++k) dst[n][k] = *(const LAS bf16x8*)(lds + PG8_SB(b, h) + boff + n * 2048 + k * 1024); } while (0)
#define PG8_MMA(ai, bj, At, Bt) do { __builtin_amdgcn_s_setprio(1); _Pragma("unroll") for (int m = 0; m < 4; ++m) _Pragma("unroll") for (int n = 0; n < 2; ++n) _Pragma("unroll") for (int k = 0; k < 2; ++k) \
        acc[ai][bj][m][n] = __builtin_amdgcn_mfma_f32_16x16x32_bf16(Bt[n][k], At[m][k], acc[ai][bj][m][n], 0, 0, 0); __builtin_amdgcn_s_setprio(0); } while (0)
#define PG8_WAIT_V(n) asm volatile("s_waitcnt vmcnt(" #n ")" ::: "memory")
#define PG8_WAIT_L(n) asm volatile("s_waitcnt lgkmcnt(" #n ")" ::: "memory")
#define PG8_BAR __builtin_amdgcn_s_barrier()
#define PG8_SCHED __builtin_amdgcn_sched_barrier(0)
    Unit cur, nxt; int ui = 0;
    if (!S.next(0, cur)) return;
    f32x4 acc[2][2][4][2];
#pragma unroll
    for (int a = 0; a < 2; ++a)
#pragma unroll
        for (int b = 0; b < 2; ++b)
#pragma unroll
            for (int m = 0; m < 4; ++m)
#pragma unroll
                for (int n = 0; n < 2; ++n) acc[a][b][m][n] = (f32x4){0.f, 0.f, 0.f, 0.f};
    bf16x8 At[4][2], B0[2][2], B1[2][2];
#define PG8_AOF(pm_) ((pm_) < g.pm_split ? (const char*)g.A + (size_t)(pm_) * tstepA : (const char*)g.A2 + (size_t)((pm_) - g.pm_split) * tstepA)
    const char* cA = PG8_AOF(cur.pm); const char* cB = (const char*)g.Bt + (size_t)cur.pn * tstepB;
    PG8_STAGE(PG8_SB(0, 0), cB, voffB); PG8_STAGE(PG8_SB(0, 1), cB + hstepB, voffB); PG8_STAGE(PG8_SA(0, 0), cA, voffA); PG8_STAGE(PG8_SA(0, 1), cA + hstepA, voffA);
    if (wr == 1) PG8_BAR;
    PG8_WAIT_V(2); PG8_BAR;
    PG8_STAGE(PG8_SB(1, 0), cB + kstep, voffB); PG8_STAGE(PG8_SA(1, 0), cA + kstep, voffA); PG8_STAGE(PG8_SB(1, 1), cB + hstepB + kstep, voffB);
    PG8_WAIT_V(6); PG8_BAR;
    for (;;) {
        const bool has_next = S.next(ui + 1, nxt);
        const char* nA = has_next ? PG8_AOF(nxt.pm) : cA; const char* nB = has_next ? (const char*)g.Bt + (size_t)nxt.pn * tstepB : cB;
        for (int t = 0; t < nt; t += 2) {
            const bool last = (t == nt - 2);
            const char* a1 = cA + (size_t)(t + 1) * kstep;
            const char* a2 = last ? nA : cA + (size_t)(t + 2) * kstep; const char* b2 = last ? nB : cB + (size_t)(t + 2) * kstep;
            const char* a3 = a2 + kstep; const char* b3 = b2 + kstep;
            PG8_LDB(B0, 0, 0); PG8_LDB(B1, 0, 1); PG8_SCHED; PG8_LDA(At, 0, 0); PG8_STAGE(PG8_SA(1, 1), a1 + hstepA, voffA);
            PG8_WAIT_V(8); PG8_WAIT_L(0); PG8_BAR; PG8_MMA(0, 0, At, B0); PG8_MMA(0, 1, At, B1); PG8_BAR; PG8_SCHED;
            PG8_LDA(At, 0, 1); PG8_STAGE(PG8_SB(0, 0), b2, voffB); PG8_STAGE(PG8_SB(0, 1), b2 + hstepB, voffB); PG8_STAGE(PG8_SA(0, 0), a2, voffA);
            PG8_WAIT_V(8); PG8_WAIT_L(0); PG8_BAR; PG8_MMA(1, 0, At, B0); PG8_MMA(1, 1, At, B1); PG8_BAR; PG8_SCHED;
            PG8_LDB(B0, 1, 0); PG8_LDB(B1, 1, 1); PG8_SCHED; PG8_LDA(At, 1, 0); PG8_STAGE(PG8_SA(0, 1), a2 + hstepA, voffA);
            PG8_WAIT_V(8); PG8_WAIT_L(0); PG8_BAR; PG8_MMA(0, 0, At, B0); PG8_MMA(0, 1, At, B1); PG8_BAR; PG8_SCHED;
            PG8_LDA(At, 1, 1); PG8_STAGE(PG8_SB(1, 0), b3, voffB); PG8_STAGE(PG8_SB(1, 1), b3 + hstepB, voffB); PG8_STAGE(PG8_SA(1, 0), a3, voffA);
            PG8_WAIT_V(8); PG8_WAIT_L(0); PG8_BAR; PG8_MMA(1, 0, At, B0); PG8_MMA(1, 1, At, B1); PG8_BAR; PG8_SCHED;
            if (E.hook_at(t + 2)) E.hook(acc, cur, t + 2, wr, wc, fr, fq);
        }
        if (wr == 0) PG8_BAR;
        E(acc, cur, wr, wc, fr, fq);
        if (!has_next) break;
#pragma unroll
        for (int a = 0; a < 2; ++a)
#pragma unroll
            for (int b = 0; b < 2; ++b)
#pragma unroll
                for (int m = 0; m < 4; ++m)
#pragma unroll
                    for (int n = 0; n < 2; ++n) acc[a][b][m][n] = (f32x4){0.f, 0.f, 0.f, 0.f};
        cur = nxt; cA = nA; cB = nB; ++ui;
        if (wr == 1) PG8_BAR;
    }
    PG8_WAIT_V(0);
    PG8_BAR;
#undef PG8_SA
#undef PG8_SB
#undef PG8_STAGE
#undef PG8_STAGE_
#undef PG8_AOF
#undef PG8_LDA
#undef PG8_LDB
#undef PG8_MMA
#undef PG8_WAIT_V
#undef PG8_WAIT_L
#undef PG8_BAR
#undef PG8_SCHED
}
}

constexpr int RING_BYTES = 131072, LDSCTL_OFF = RING_BYTES, XCH_OFF = RING_BYTES + 1024, LDS_BYTES = 147456;
enum EpiMode { E_PROJ = 0, E_MKV, E_BR, E_WO, E_FFI, E_FFO };
__device__ __forceinline__ float sigmoidf_(float v) { return __builtin_amdgcn_rcpf(1.0f + __builtin_amdgcn_exp2f(-v * LOG2E)); }
__device__ __forceinline__ float sum_fq(float s) {
    s += __int_as_float(__builtin_amdgcn_ds_swizzle(__float_as_int(s), 0x401F));
    const auto rr = __builtin_amdgcn_permlane32_swap(__float_as_uint(s), __float_as_uint(s), false, false);
    const unsigned x = rr[0], y = rr[1];
    return __uint_as_float(x) + __uint_as_float(y);
}
struct EpiRT {
    int mode; const Frame* Fp; bool dry;
    __device__ __forceinline__ bool hook_at(int kt) const { return mode == E_BR && (kt == 4 || kt == 16); }
    __device__ __forceinline__ void hook(f32x4 (&acc)[2][2][4][2], const pg8::Unit& u, int kt, int wr, int wc, int fr, int fq) const {
        const Frame& F = *Fp;
        int ln_ = (int)__builtin_amdgcn_mbcnt_hi(~0u, __builtin_amdgcn_mbcnt_lo(~0u, 0u)); asm volatile("" : "+v"(ln_));
        const int fr_ = ln_ & 15, fq_ = ln_ >> 4; (void)fr; (void)fq;
        const int rowb = u.pm * 256 + wr * 64 + fr_, colb = u.pn * 256 + wc * 32 + 8 * fq_, gi = (kt == 4) ? 0 : 1;
#pragma unroll
        for (int ai = 0; ai < 2; ++ai) {
            u32x4 ga[4][2], gb[4][2];
#pragma unroll
            for (int m = 0; m < 4; ++m)
#pragma unroll
                for (int bj = 0; bj < 2; ++bj) { const bf16_t* gp = F_GATES + (size_t)(rowb + ai * 128 + m * 16) * GATEW + gi * DM + colb + bj * 128; ga[m][bj] = *(const u32x4*)gp; gb[m][bj] = *(const u32x4*)(gp + DM); }
#pragma unroll
            for (int m = 0; m < 4; ++m)
#pragma unroll
                for (int bj = 0; bj < 2; ++bj) { const u32x4 a = ga[m][bj], b = gb[m][bj];
                    f32x4 r0, r1;
                    r0[0] = bf_lo(a.x) * __builtin_amdgcn_rcpf(bf_lo(b.x)); r0[1] = bf_hi(a.x) * __builtin_amdgcn_rcpf(bf_hi(b.x)); r0[2] = bf_lo(a.y) * __builtin_amdgcn_rcpf(bf_lo(b.y)); r0[3] = bf_hi(a.y) * __builtin_amdgcn_rcpf(bf_hi(b.y));
                    r1[0] = bf_lo(a.z) * __builtin_amdgcn_rcpf(bf_lo(b.z)); r1[1] = bf_hi(a.z) * __builtin_amdgcn_rcpf(bf_hi(b.z)); r1[2] = bf_lo(a.w) * __builtin_amdgcn_rcpf(bf_lo(b.w)); r1[3] = bf_hi(a.w) * __builtin_amdgcn_rcpf(bf_hi(b.w));
                    acc[ai][bj][m][0] *= r0; acc[ai][bj][m][1] *= r1; }
            asm volatile("" ::: "memory"); }
    }
    __device__ __forceinline__ void operator()(const f32x4 (&acc)[2][2][4][2], const pg8::Unit& u0, int wr, int wc, int fr0, int fq0) const {
        const Frame& F = *Fp;
        int ln_ = (int)__builtin_amdgcn_mbcnt_hi(~0u, __builtin_amdgcn_mbcnt_lo(~0u, 0u)); asm volatile("" : "+v"(ln_));
        const int fr = ln_ & 15, fq = ln_ >> 4; (void)fr0; (void)fq0;
        const bool mkvx = (mode == E_PROJ) && (u0.pm >= T / 256);
        pg8::Unit u = u0; if (mkvx) { u.pm -= T / 256; u.pn -= INW / 256; }
        const int md = mkvx ? (int)E_MKV : mode;
        const int rowb = u.pm * 256 + wr * 64 + fr, colb = u.pn * 256 + wc * 32 + 8 * fq;
        if (md == E_PROJ || md == E_MKV) {
            const bool gate = (md == E_PROJ) && (u.pn >= 16);
            bf16_t* base; int ld, c0; const float* gptr = nullptr; bool rope = false; float sc = 1.f;
            if (md == E_MKV) { base = F_MKV; ld = 1024; c0 = colb; if (u.pn < 2) gptr = F_g_kc; }
            else if (!gate) { base = F_QKV; ld = QKVW; c0 = colb; const int pn = u.pn;
                if (pn < 3) { gptr = F_g_qa; sc = QSCALE; } else if (pn < 6) gptr = F_g_ka; else if (pn < 9) {} else if (pn < 12) { gptr = F_g_qb; rope = true; sc = QSCALE; }
                else if (pn == 12) { gptr = F_g_kb; rope = true; } else if (pn == 13) {} else { gptr = F_g_qc; sc = QSCALE; } }
            else { base = F_GATES; ld = GATEW; c0 = colb - QKVW; }
            f32x4 g0 = {1.f, 1.f, 1.f, 1.f}, g1 = g0;
            float rx[2][4];
#pragma unroll
            for (int ai = 0; ai < 2; ++ai)
#pragma unroll
                for (int m = 0; m < 4; ++m) rx[ai][m] = (md == E_PROJ) ? F_rx[rowb + ai * 128 + m * 16] : 1.0f;
            LAS float* P = (LAS float*)(F.lds + XCH_OFF);
            if (gptr) {
#pragma unroll
                for (int ai = 0; ai < 2; ++ai)
#pragma unroll
                    for (int m = 0; m < 4; ++m)
#pragma unroll
                        for (int bj = 0; bj < 2; ++bj) { const f32x4 a = acc[ai][bj][m][0], b = acc[ai][bj][m][1];
                            float ss = (a[0] * a[0] + a[1] * a[1]) + (a[2] * a[2] + a[3] * a[3]) + (b[0] * b[0] + b[1] * b[1]) + (b[2] * b[2] + b[3] * b[3]);
                            ss = sum_fq(ss);
                            if (fq == 0) P[(ai * 128 + wr * 64 + m * 16 + fr) * 8 + bj * 4 + wc] = ss; }
                asm volatile("s_waitcnt lgkmcnt(0)" ::: "memory"); __builtin_amdgcn_s_barrier(); asm volatile("" ::: "memory");
                g0 = *(const f32x4*)(gptr + wc * 32 + 8 * fq); g1 = *(const f32x4*)(gptr + wc * 32 + 8 * fq + 4);
            }
#pragma unroll
            for (int ai = 0; ai < 2; ++ai)
#pragma unroll
                for (int m = 0; m < 4; ++m) { const int row = rowb + ai * 128 + m * 16; bf16_t* rowp = base + (size_t)row * ld + c0;
                    f32x4 cs0 = {1.f, 0.f, 1.f, 0.f}, cs1 = cs0; const float rxv = rx[ai][m], nrl = -rxv * LOG2E;
                    if (rope) { const int s = row & (SEQ - 1), pos = (wc < 2) ? (s >> 6) : (s & 63); const float* rp = (const float*)(F_rope + pos * 32 + 16 * (wc & 1) + 4 * fq);
                        cs0 = *(const f32x4*)rp; cs1 = *(const f32x4*)(rp + 4); }
#pragma unroll
                    for (int bj = 0; bj < 2; ++bj) { f32x4 v0 = acc[ai][bj][m][0], v1 = acc[ai][bj][m][1];
                        if (gate) {
#pragma unroll
                            for (int j = 0; j < 4; ++j) { v0[j] = __builtin_amdgcn_rcpf(1.0f + __builtin_amdgcn_exp2f(v0[j] * nrl)); v1[j] = __builtin_amdgcn_rcpf(1.0f + __builtin_amdgcn_exp2f(v1[j] * nrl)); } }
                        else if (gptr) { const f32x4 q = *(const LAS f32x4*)(P + (ai * 128 + wr * 64 + m * 16 + fr) * 8 + bj * 4);
                            const float r = sc * rxv / sqrtf(((q[0] + q[1]) + (q[2] + q[3])) * (rxv * rxv * (1.0f / HD)) + EPS); v0 = v0 * g0 * r; v1 = v1 * g1 * r;
                            if (rope) { f32x4 t0, t1;
                                t0[0] = v0[0] * cs0[0] - v0[1] * cs0[1]; t0[1] = v0[0] * cs0[1] + v0[1] * cs0[0]; t0[2] = v0[2] * cs0[2] - v0[3] * cs0[3]; t0[3] = v0[2] * cs0[3] + v0[3] * cs0[2];
                                t1[0] = v1[0] * cs1[0] - v1[1] * cs1[1]; t1[1] = v1[0] * cs1[1] + v1[1] * cs1[0]; t1[2] = v1[2] * cs1[2] - v1[3] * cs1[3]; t1[3] = v1[2] * cs1[3] + v1[3] * cs1[2];
                                v0 = t0; v1 = t1; } }
                        else { v0 = v0 * rxv; v1 = v1 * rxv; }
                        u32x4 w; w.x = cvtpk(v0[0], v0[1]); w.y = cvtpk(v0[2], v0[3]); w.z = cvtpk(v1[0], v1[1]); w.w = cvtpk(v1[2], v1[3]);
                        *(u32x4*)(rowp + bj * 128) = w; } }
        } else if (mode == E_BR) {
#pragma unroll
            for (int ai = 0; ai < 2; ++ai) {
                u32x4 gw[4][2];
#pragma unroll
                for (int m = 0; m < 4; ++m)
#pragma unroll
                    for (int bj = 0; bj < 2; ++bj) gw[m][bj] = *(const u32x4*)(F_GATES + (size_t)(rowb + ai * 128 + m * 16) * GATEW + 2 * DM + colb + bj * 128);
#pragma unroll
                for (int m = 0; m < 4; ++m)
#pragma unroll
                    for (int bj = 0; bj < 2; ++bj) { const u32x4 g = gw[m][bj];
                        const f32x4 g0 = {bf_lo(g.x), bf_hi(g.x), bf_lo(g.y), bf_hi(g.y)}, g1 = {bf_lo(g.z), bf_hi(g.z), bf_lo(g.w), bf_hi(g.w)};
                        const f32x4 v0 = acc[ai][bj][m][0] * g0, v1 = acc[ai][bj][m][1] * g1;
                        u32x4 w; w.x = cvtpk(v0[0], v0[1]); w.y = cvtpk(v0[2], v0[3]); w.z = cvtpk(v1[0], v1[1]); w.w = cvtpk(v1[2], v1[3]);
                        *(u32x4*)(F_GATES + (size_t)(rowb + ai * 128 + m * 16) * GATEW + colb + bj * 128) = w; }
                asm volatile("" ::: "memory"); }
        } else if (mode == E_WO) {
            const GAS char* xb_ = (const GAS char*)F_HB1 + ((size_t)(u.pm * 256 + wr * 64) * DM + u.pn * 256 + wc * 32) * 2;
            const unsigned xl_ = (unsigned)(fr * DM + 8 * fq) * 2u;
            LAS float* PW = (LAS float*)(F.lds + XCH_OFF);
            u32x4 xa[2][4][2];
#pragma unroll
            for (int ai = 0; ai < 2; ++ai)
#pragma unroll
                for (int m = 0; m < 4; ++m)
#pragma unroll
                    for (int bj = 0; bj < 2; ++bj) xa[ai][m][bj] = *(const GAS u32x4*)(xb_ + ((size_t)(ai * 128 + m * 16) * DM + bj * 128) * 2 + xl_);
#pragma unroll
            for (int ai = 0; ai < 2; ++ai) {
#pragma unroll
                for (int m = 0; m < 4; ++m) { const size_t row = (size_t)(rowb + ai * 128 + m * 16); float s = 0.f;
#pragma unroll
                    for (int bj = 0; bj < 2; ++bj) { const int c = colb + bj * 128; const u32x4 g = xa[ai][m][bj];
                        const f32x4 x0 = {bf_lo(g.x), bf_hi(g.x), bf_lo(g.y), bf_hi(g.y)}, x1 = {bf_lo(g.z), bf_hi(g.z), bf_lo(g.w), bf_hi(g.w)};
                        const f32x4 v0 = acc[ai][bj][m][0] + x0, v1 = acc[ai][bj][m][1] + x1;
                        u32x4 w; w.x = cvtpk(v0[0], v0[1]); w.y = cvtpk(v0[2], v0[3]); w.z = cvtpk(v1[0], v1[1]); w.w = cvtpk(v1[2], v1[3]);
                        *(u32x4*)(F_X1B + row * DM + c) = w;
                        s += (v0[0] * v0[0] + v0[1] * v0[1]) + (v0[2] * v0[2] + v0[3] * v0[3]) + (v1[0] * v1[0] + v1[1] * v1[1]) + (v1[2] * v1[2] + v1[3] * v1[3]); }
                    s = sum_fq(s);
                    if (fq == 0) PW[(ai * 128 + wr * 64 + m * 16 + fr) * 4 + wc] = s; }
                asm volatile("" ::: "memory"); }
            asm volatile("s_waitcnt lgkmcnt(0)" ::: "memory"); __builtin_amdgcn_s_barrier(); asm volatile("" ::: "memory");
            { const int t_ = (int)__builtin_amdgcn_readfirstlane(wr * 4 + wc) * 64 + ln_;
              if (t_ < 256 && !dry) { const f32x4 q = *(const LAS f32x4*)(PW + t_ * 4); atomicAdd(F_ssq + (size_t)(u.pm * 256 + t_), (q[0] + q[1]) + (q[2] + q[3])); } }
        } else if (mode == E_FFI) {
            float rr[2][4];
#pragma unroll
            for (int ai = 0; ai < 2; ++ai)
#pragma unroll
                for (int m = 0; m < 4; ++m) rr[ai][m] = F_ssq[rowb + ai * 128 + m * 16];
#pragma unroll
            for (int ai = 0; ai < 2; ++ai)
#pragma unroll
                for (int m = 0; m < 4; ++m) { const size_t row = (size_t)(rowb + ai * 128 + m * 16);
                    const float r = __builtin_amdgcn_rsqf(rr[ai][m] * (1.0f / DM) + EPS), r2_ = r * r, nrl_ = -r * LOG2E;
                    f32x4 o[2];
#pragma unroll
                    for (int n = 0; n < 2; ++n)
#pragma unroll
                        for (int j = 0; j < 4; ++j) { const float a_ = acc[ai][0][m][n][j]; o[n][j] = (a_ * acc[ai][1][m][n][j]) * r2_ * __builtin_amdgcn_rcpf(1.0f + __builtin_amdgcn_exp2f(a_ * nrl_)); }
                    u32x4 w; w.x = cvtpk(o[0][0], o[0][1]); w.y = cvtpk(o[0][2], o[0][3]); w.z = cvtpk(o[1][0], o[1][1]); w.w = cvtpk(o[1][2], o[1][3]);
                    *(u32x4*)(F_ACT + row * DFF + u.pn * 128 + wc * 32 + 8 * fq) = w; }
        } else {
            const float k_ = dry ? 0.f : 1.f;
            const GAS char* xb_ = (const GAS char*)F_X1B + ((size_t)(u.pm * 256 + wr * 64) * DM + u.pn * 256 + wc * 32) * 2;
            const unsigned xl_ = (unsigned)(fr * DM + 8 * fq) * 2u;
            u32x4 xa[2][4][2];
#pragma unroll
            for (int ai = 0; ai < 2; ++ai)
#pragma unroll
                for (int m = 0; m < 4; ++m)
#pragma unroll
                    for (int bj = 0; bj < 2; ++bj) xa[ai][m][bj] = *(const GAS u32x4*)(xb_ + ((size_t)(ai * 128 + m * 16) * DM + bj * 128) * 2 + xl_);
#pragma unroll
            for (int ai = 0; ai < 2; ++ai) {
#pragma unroll
                for (int m = 0; m < 4; ++m)
#pragma unroll
                    for (int bj = 0; bj < 2; ++bj) { float* op = F_out + (size_t)(rowb + ai * 128 + m * 16) * DM + colb + bj * 128; const u32x4 g = xa[ai][m][bj];
                        const f32x4 x0 = {bf_lo(g.x), bf_hi(g.x), bf_lo(g.y), bf_hi(g.y)}, x1 = {bf_lo(g.z), bf_hi(g.z), bf_lo(g.w), bf_hi(g.w)};
                        *(f32x4*)op = acc[ai][bj][m][0] * k_ + x0; *(f32x4*)(op + 4) = acc[ai][bj][m][1] * k_ + x1; }
                asm volatile("" ::: "memory"); }
        }
    }
};

#define XB_TMO      128
#define XB_XCNT(j)  (256  + 64 * (j))
#define XB_XSUB(j)  (1280 + 64 * (j))
#define XB_XGEN(j)  (2304 + 64 * (j))
#define XB_TOP      3328
#define XB_TOPGEN   3392
#define XCD_BAR_WORDS 3456
#define XB_SPIN_CAP (1u << 18)
__device__ __forceinline__ unsigned xb_ld(unsigned* p)              { return __hip_atomic_load(p, __ATOMIC_RELAXED, __HIP_MEMORY_SCOPE_AGENT); }
__device__ __forceinline__ unsigned xb_add(unsigned* p, unsigned v) { return __hip_atomic_fetch_add(p, v, __ATOMIC_RELAXED, __HIP_MEMORY_SCOPE_AGENT); }
__device__ __forceinline__ unsigned xb_xcc_id() { return (unsigned)__builtin_amdgcn_s_getreg((3 << 11) | 20) & 0xFu; }
#define XB_SPIN(cond, bar) do { unsigned _sp = 0; while (cond) { __builtin_amdgcn_s_sleep(1); \
    if ((++_sp & 255u) == 0u) { if (xb_ld(&(bar)[XB_TMO])) break; if (_sp > XB_SPIN_CAP) { atomicAdd(&(bar)[XB_TMO], 1u); break; } } } } while (0)
struct XcdBarrier { unsigned* bar; unsigned x; volatile LAS unsigned* st; };
__device__ __forceinline__ XcdBarrier xcd_barrier_post(unsigned* bar, volatile LAS unsigned* st) {
    XcdBarrier b; b.bar = bar; b.x = xb_xcc_id(); b.st = st;
    if (threadIdx.x == 0) (void)xb_add(&bar[XB_XCNT(b.x)], 1u);
    return b;
}
__device__ __forceinline__ void xcd_barrier_complete(unsigned* bar, unsigned x, unsigned& nloc, unsigned& nx) {
    const unsigned G = gridDim.x * gridDim.y * gridDim.z;
    unsigned sum, cnt, mine, sp = 0u;
    for (;;) {
        sum = 0u; cnt = 0u; mine = 0u;
#pragma unroll
        for (unsigned j = 0; j < 16; ++j) { const unsigned c = xb_ld(&bar[XB_XCNT(j)]); sum += c; cnt += (c > 0u) ? 1u : 0u; mine = (j == x) ? c : mine; }
        if (sum == G) break;
        __builtin_amdgcn_s_sleep(1);
        if ((++sp & 255u) == 0u) { if (xb_ld(&bar[XB_TMO])) break; if (sp > XB_SPIN_CAP) { atomicAdd(&bar[XB_TMO], 1u); break; } }
    }
    nloc = mine > 0u ? mine : 1u; nx = cnt > 0u ? cnt : 1u;
}
__device__ __forceinline__ void xcd_barrier(const XcdBarrier& b) {
    asm volatile("s_waitcnt vmcnt(0)" ::: "memory");
    __syncthreads();
    if (threadIdx.x == 0) {
        unsigned* bar = b.bar;
        __builtin_amdgcn_s_waitcnt(0);
        unsigned nloc = b.st[0], nx = b.st[1];
        if (nloc == 0u) { xcd_barrier_complete(bar, b.x, nloc, nx); b.st[0] = nloc; b.st[1] = nx; }
        const unsigned old = xb_add(&bar[XB_XSUB(b.x)], 1u);
        const unsigned gen = old / nloc;
        if (old + 1u == (gen + 1u) * nloc) {
            __builtin_amdgcn_fence(__ATOMIC_RELEASE, "agent");
            asm volatile("s_waitcnt vmcnt(0)" ::: "memory");
            const unsigned og = xb_add(&bar[XB_TOP], 1u);
            const unsigned tg = og / nx;
            if (og + 1u == (tg + 1u) * nx) xb_add(&bar[XB_TOPGEN], 1u);
            else XB_SPIN(xb_ld(&bar[XB_TOPGEN]) == tg, bar);
            __builtin_amdgcn_fence(__ATOMIC_ACQUIRE, "agent");
            asm volatile("s_waitcnt vmcnt(0)" ::: "memory");
        } else {
            XB_SPIN(xb_ld(&bar[XB_TOPGEN]) == gen, bar);
            __builtin_amdgcn_fence(__ATOMIC_ACQUIRE, "agent");
            asm volatile("s_waitcnt vmcnt(0)" ::: "memory");
        }
    }
    __syncthreads();
}

struct TJob { const float* src; bf16_t* dst; const float* gain; int N, ldk, k0, n0, drow; };
__device__ __forceinline__ TJob tjob_plain(const float* W, int N, bf16_t* WT, int ldk, int item) { const int nblk = N / 32, kb = item / nblk, nb = item % nblk; return TJob{W, WT, nullptr, N, ldk, 64 * kb, 32 * nb, 32 * nb}; }
constexpr int TJ_IN = (DM / 64) * (INW / 32), TJ_MKV = (DM / 64) * (1024 / 32), TJ_FO = (DFF / 64) * (DM / 32), TJ_N0 = TJ_IN + TJ_MKV + TJ_FO;
constexpr int TJ_A = (256 / 64) * (DM / 32), TJ_B = (768 / 64) * (DM / 32), TJ_C = (512 / 64) * (DM / 32), TJ_O = (DM / 64) * (DM / 32), TJ_FI = (DM / 64) * (2 * DFF / 32);
constexpr int TJ_N1 = TJ_A + TJ_B + TJ_C + TJ_O + TJ_FI;
__device__ __forceinline__ TJob tjob(const Frame& F, int list, int it) {
    if (list == 0) { if (it < TJ_IN) { TJob j = tjob_plain(F_w_in, INW, F_Win, DM, it); j.gain = F_g_mix; return j; } if (it < TJ_IN + TJ_MKV) return tjob_plain(F_w_mem_kv, 1024, F_Wmkv, DM, it - TJ_IN); return tjob_plain(F_w_ffn_out, DM, F_Wfo, DFF, it - TJ_IN - TJ_MKV); }
    int r = it;
    if (r < TJ_A) return tjob_plain(F_w_br_a, DM, F_Wbr + O_A, OALLW, r); r -= TJ_A;
    if (r < TJ_B) return tjob_plain(F_w_br_b, DM, F_Wbr + O_B, OALLW, r); r -= TJ_B;
    if (r < TJ_C) return tjob_plain(F_w_br_c, DM, F_Wbr + O_C, OALLW, r); r -= TJ_C;
    if (r < TJ_O) return tjob_plain(F_w_o, DM, F_Wo, DM, r); r -= TJ_O;
    const int nblk = (2 * DFF) / 32, kb = r / nblk, nb = r % nblk, n0 = 32 * nb; const int isup = n0 >= DFF, h0 = isup ? n0 - DFF : n0;
    return TJob{F_w_ffn_in, F_Wfi, F_g_ffn, 2 * DFF, DM, 64 * kb, n0, 256 * (h0 / 128) + (isup ? 128 : 0) + (h0 % 128)};
}
__device__ __forceinline__ void tjob_load(const TJob& j, float (&v)[32], int lane) {
    const float* p = j.src + (size_t)(j.k0 + (lane >> 5)) * j.N + j.n0 + (lane & 31);
#pragma unroll
    for (int i = 0; i < 32; ++i) v[i] = __builtin_nontemporal_load(&p[(size_t)(2 * i) * j.N]);
}
__device__ __forceinline__ void tjob_store(const TJob& j, const float (&v)[32], LAS float* scr, int lane) {
    const int c = lane & 7;
    f32x4 ga = {1.f, 1.f, 1.f, 1.f}, gb = ga;
    if (j.gain) { ga = *(const f32x4*)(j.gain + j.k0 + 8 * c); gb = *(const f32x4*)(j.gain + j.k0 + 8 * c + 4); }
#pragma unroll
    for (int i = 0; i < 32; ++i) scr[(2 * i + (lane >> 5)) * 33 + (lane & 31)] = v[i];
    LDS_WAIT(); asm volatile("" ::: "memory");
#pragma unroll
    for (int q = 0; q < 4; ++q) { const int n = (lane >> 3) + 8 * q; const LAS float* s = scr + (8 * c) * 33 + n;
        u32x4 o; o.x = cvtpk(s[0 * 33] * ga[0], s[1 * 33] * ga[1]); o.y = cvtpk(s[2 * 33] * ga[2], s[3 * 33] * ga[3]); o.z = cvtpk(s[4 * 33] * gb[0], s[5 * 33] * gb[1]); o.w = cvtpk(s[6 * 33] * gb[2], s[7 * 33] * gb[3]);
        *(u32x4*)(j.dst + (size_t)(j.drow + n) * j.ldk + j.k0 + 8 * c) = o; }
    LDS_WAIT(); asm volatile("" ::: "memory");
}
__device__ __forceinline__ void tjob_run(const Frame& F, int list, int njobs, int gw, int NGW) {
    LAS float* scr = (LAS float*)(F.lds + F.wave * 16384);
    float va[32], vb[32];
    int it = gw; if (it >= njobs) return;
    TJob ja = tjob(F, list, it), jb = ja; tjob_load(ja, va, F.lane);
    for (;;) {
        const bool hb = it + NGW < njobs; if (hb) { jb = tjob(F, list, it + NGW); tjob_load(jb, vb, F.lane); }
        tjob_store(ja, va, scr, F.lane); if (!hb) break; it += NGW;
        const bool ha = it + NGW < njobs; if (ha) { ja = tjob(F, list, it + NGW); tjob_load(ja, va, F.lane); }
        tjob_store(jb, vb, scr, F.lane); if (!ha) break; it += NGW;
    }
}
__device__ __forceinline__ void raw_row_to_bf16(const float* xrow, bf16_t* orow, float* rout, int lane) {
    const f32x4* xr = (const f32x4*)xrow + lane; u32x2* o8 = (u32x2*)orow + lane; float s = 0.f;
    f32x4 v[8];
#pragma unroll
    for (int j = 0; j < 8; ++j) v[j] = __builtin_nontemporal_load(&xr[64 * j]);
#pragma unroll
    for (int j = 0; j < 8; ++j) { s += (v[j].x * v[j].x + v[j].y * v[j].y) + (v[j].z * v[j].z + v[j].w * v[j].w); u32x2 w; w.x = cvtpk(v[j].x, v[j].y); w.y = cvtpk(v[j].z, v[j].w); o8[64 * j] = w; }
    const float r = 1.0f / sqrtf(wave_sum(s) * (1.0f / DM) + EPS);
    if (lane == 0) *rout = r;
}
__device__ __forceinline__ void rms_row_to_bf16(const float* xrow, const float* g, bf16_t* orow, int lane) {
    const f32x4* xr = (const f32x4*)xrow + lane; const f32x4* gr = (const f32x4*)g + lane;
    f32x4 v[8]; float s = 0.f;
#pragma unroll
    for (int j = 0; j < 8; ++j) { v[j] = __builtin_nontemporal_load(&xr[64 * j]); s += (v[j].x * v[j].x + v[j].y * v[j].y) + (v[j].z * v[j].z + v[j].w * v[j].w); }
    const float r = 1.0f / sqrtf(wave_sum(s) * (1.0f / DM) + EPS);
    u32x2* o8 = (u32x2*)orow + lane;
#pragma unroll
    for (int j = 0; j < 8; ++j) { const f32x4 gg = gr[64 * j]; u32x2 w; w.x = cvtpk(v[j].x * r * gg.x, v[j].y * r * gg.y); w.y = cvtpk(v[j].z * r * gg.z, v[j].w * r * gg.w); o8[64 * j] = w; }
}
__device__ __forceinline__ int t5_bucket(int rel) {
    const int nb = 16, max_exact = 8; int ret = rel > 0 ? nb : 0; const int n = rel < 0 ? -rel : rel;
    int large = max_exact + (int)(logf((float)(n > 1 ? n : 1) / (float)max_exact) / logf(1024.0f / 8.0f) * (float)(nb - max_exact));
    large = large < nb - 1 ? large : nb - 1;
    return ret + (n < max_exact ? n : large);
}
__device__ __forceinline__ void p0_convert_late(const Frame& F, int rank, int nrank) {
    tjob_run(F, 1, TJ_N1, rank * 8 + F.wave, nrank * 8);
}
__device__ __forceinline__ void p0_prologue(const Frame& F) {
    const int gw = F.vcu * 8 + F.wave, NGW = F.G * 8;
    tjob_run(F, 0, TJ_N0, gw, NGW);
    for (int m = NGW - 1 - gw; m < T + TM; m += NGW) {
        if (m < T) raw_row_to_bf16(F_x + (size_t)m * DM, (m < HB_SPLIT ? F_HB1 + (size_t)m * DM : F_HB2 + (size_t)(m - HB_SPLIT) * DM), F_rx + m, F.lane);
        else rms_row_to_bf16(F_mem + (size_t)(m - T) * DM, F_g_mem, F_MEMN + (size_t)(m - T) * DM, F.lane);
    }
    const int gt = (F.vcu * 512 + F.tid), NGT = F.G * 512;
    for (int i = gt; i < 64 * 32; i += NGT) { const int p = i >> 5, fi = i & 31;
        const float inv = __builtin_amdgcn_exp2f(-(float)fi * (13.287712379549449f / 32.0f));
        const float ang = (float)p * inv;
        const float kf = __builtin_rintf(ang * 0.63661977236758134f); const int kq = (int)kf;
        float r = __builtin_fmaf(-kf, 1.5707963705062866f, ang); r = __builtin_fmaf(-kf, -4.37113883e-8f, r);
        const float r2 = r * r;
        const float sn = r * (1.0f - r2 * (1.0f / 6.0f) * (1.0f - r2 * (1.0f / 20.0f) * (1.0f - r2 * (1.0f / 42.0f) * (1.0f - r2 * (1.0f / 72.0f) * (1.0f - r2 * (1.0f / 110.0f))))));
        const float cs = 1.0f - r2 * 0.5f * (1.0f - r2 * (1.0f / 12.0f) * (1.0f - r2 * (1.0f / 30.0f) * (1.0f - r2 * (1.0f / 56.0f) * (1.0f - r2 * (1.0f / 90.0f) * (1.0f - r2 * (1.0f / 132.0f))))));
        const int qd = kq & 3; const float c = qd == 0 ? cs : (qd == 1 ? -sn : (qd == 2 ? -cs : sn)), sv = qd == 0 ? sn : (qd == 1 ? cs : (qd == 2 ? -sn : -cs));
        F_rope[i] = (f32x2){c, sv}; }
    for (int i = gt; i < 6 * 160; i += NGT) { const int hh = i / 160, idx = i % 160; const int g = hh >> 1; const int dil = g == 0 ? 1 : (g == 1 ? 4 : 16);
        float v = 0.f; if (idx <= 128) v = F_rel_bias[t5_bucket((idx - 64) * dil) * 6 + hh] * LOG2E; F_biasT[i] = v; }
}

__device__ __forceinline__ int crow(int r, int hi) { return (r & 3) + 8 * (r >> 2) + 4 * hi; }
namespace attnb {
using s16x4  = __attribute__((ext_vector_type(4))) short;
constexpr int D = 128, NW = 8, QBLK = 32, KVBLK = 64;
constexpr float THRL = 8.f * 1.4426950408889634f;
constexpr int SDEPTH = 2;
constexpr size_t SHM_V = KVBLK * D * 2, SHM_K = KVBLK * D * 2, SHM_ATTN = 2 * SHM_V + 2 * SHM_K + NW * 64 * 4;
#define KSWZ(row, colB) ((row) * 256 + ((colB) ^ (((row) & 7) << 4)))
#define SBAR() __builtin_amdgcn_sched_barrier(0)
__device__ __forceinline__ unsigned cvtpk_a(float lo, float hi) { unsigned r; asm volatile("v_cvt_pk_bf16_f32 %0, %1, %2" : "=v"(r) : "v"(lo), "v"(hi)); return r; }
__device__ __forceinline__ void partialSM(f32x16& p0, f32x16& p1, float& m_reg, float& mn, float& alpha) {
  float pmax = p0[0]; for (int r = 1; r < 16; ++r) pmax = fmaxf(pmax, p0[r]); for (int r = 0; r < 16; ++r) pmax = fmaxf(pmax, p1[r]);
  { auto rr = __builtin_amdgcn_permlane32_swap(__float_as_uint(pmax), __float_as_uint(pmax), false, false);
    pmax = fmaxf(__uint_as_float(rr[0]), __uint_as_float(rr[1])); }
  if (__builtin_expect(__all(pmax - m_reg <= THRL), 1)) { mn = m_reg; alpha = 1.f; }
  else { mn = fmaxf(m_reg, pmax); alpha = __builtin_amdgcn_exp2f(m_reg - mn); m_reg = mn; }
  for (int r = 0; r < 16; ++r) p0[r] = p0[r] - mn; for (int r = 0; r < 16; ++r) p1[r] = p1[r] - mn;
  for (int r = 0; r < 16; ++r) p0[r] = __builtin_amdgcn_exp2f(p0[r]);
}
__device__ __forceinline__ void finishSM(f32x16& p0, f32x16& p1, float alpha, float& l_reg, bf16x8& pa0, bf16x8& pa1, bf16x8& pa2, bf16x8& pa3) {
  for (int r = 0; r < 16; ++r) p1[r] = __builtin_amdgcn_exp2f(p1[r]);
  float ps = 0; for (int r = 0; r < 16; ++r) ps += p0[r]; for (int r = 0; r < 16; ++r) ps += p1[r];
  { auto rr = __builtin_amdgcn_permlane32_swap(__float_as_uint(ps), __float_as_uint(ps), false, false);
    ps = __uint_as_float(rr[0]) + __uint_as_float(rr[1]); }
  l_reg = l_reg * alpha + ps;
#define PK4(P, BASE, OUT) do { unsigned a0 = cvtpk_a(P[BASE + 0], P[BASE + 1]), a1 = cvtpk_a(P[BASE + 2], P[BASE + 3]);   \
    unsigned b0 = cvtpk_a(P[BASE + 4], P[BASE + 5]), b1 = cvtpk_a(P[BASE + 6], P[BASE + 7]);                              \
    auto r0 = __builtin_amdgcn_permlane32_swap(a0, b0, false, false); auto r1 = __builtin_amdgcn_permlane32_swap(a1, b1, false, false); \
    u32x4 w = {r0[0], r1[0], r0[1], r1[1]}; OUT = *reinterpret_cast<bf16x8*>(&w); } while (0)
  PK4(p0, 0, pa0); PK4(p0, 8, pa1); PK4(p1, 0, pa2); PK4(p1, 8, pa3);
#undef PK4
}
__device__ __forceinline__ void qkt(f32x16& p0, f32x16& p1, const bf16_t* Ks, const bf16x8* qr, int r32, int hi) {
  p0 = f32x16{}; p1 = f32x16{};
  for (int d0 = 0; d0 < 8; ++d0) { int cb = (d0 * 16 + hi * 8) * 2;
    bf16x8 b0 = *reinterpret_cast<const bf16x8*>((const char*)Ks + KSWZ(r32, cb));
    bf16x8 b1 = *reinterpret_cast<const bf16x8*>((const char*)Ks + KSWZ(32 + r32, cb));
    p0 = __builtin_amdgcn_mfma_f32_32x32x16_bf16(b0, qr[d0], p0, 0, 0, 0);
    p1 = __builtin_amdgcn_mfma_f32_32x32x16_bf16(b1, qr[d0], p1, 0, 0, 0); }
}
__device__ __forceinline__ int v_st(int k, int c) { const int kk = (k & ~0xC) | ((k & 4) << 1) | ((k & 8) >> 1); return ((kk >> 3) * 4 + (c >> 5)) * 512 + ((kk & 7) * 32 + (c & 31)) * 2; }
__device__ __forceinline__ int v_rd_base(int lane) { return ((lane & 3) << 3) | (((lane >> 2) & 3) << 6) | (((lane >> 4) & 1) << 5) | (((lane >> 5) & 1) << 8); }
constexpr int v_rd_off(int d0, int ks, int half) { return d0 * 512 + ks * 4096 + half * 2048; }
template <int OFF> __device__ __forceinline__ s16x4 tr_read(int vb) {
  s16x4 r; asm volatile("ds_read_b64_tr_b16 %0, %1 offset:%2" : "=&v"(r) : "v"(vb), "i"(OFF) : "memory"); return r;
}
template <int D0> __device__ __forceinline__ void pv_one(f32x16& od, int vb, bf16x8 pa0, bf16x8 pa1, bf16x8 pa2, bf16x8 pa3) {
  const s16x4 l0 = tr_read<v_rd_off(D0, 0, 0)>(vb), h0 = tr_read<v_rd_off(D0, 0, 1)>(vb), l1 = tr_read<v_rd_off(D0, 1, 0)>(vb), h1 = tr_read<v_rd_off(D0, 1, 1)>(vb);
  const s16x4 l2 = tr_read<v_rd_off(D0, 2, 0)>(vb), h2 = tr_read<v_rd_off(D0, 2, 1)>(vb), l3 = tr_read<v_rd_off(D0, 3, 0)>(vb), h3 = tr_read<v_rd_off(D0, 3, 1)>(vb);
  asm volatile("s_waitcnt lgkmcnt(0)" ::: "memory"); SBAR();
#define PK(L, H) (bf16x8){L[0], L[1], L[2], L[3], H[0], H[1], H[2], H[3]}
  od = __builtin_amdgcn_mfma_f32_32x32x16_bf16(pa0, PK(l0, h0), od, 0, 0, 0);
  od = __builtin_amdgcn_mfma_f32_32x32x16_bf16(pa1, PK(l1, h1), od, 0, 0, 0);
  od = __builtin_amdgcn_mfma_f32_32x32x16_bf16(pa2, PK(l2, h2), od, 0, 0, 0);
  od = __builtin_amdgcn_mfma_f32_32x32x16_bf16(pa3, PK(l3, h3), od, 0, 0, 0);
#undef PK
}
__device__ __forceinline__ void pv_d0(f32x16* o, int vb, bf16x8 pa0, bf16x8 pa1, bf16x8 pa2, bf16x8 pa3) {
  pv_one<0>(o[0], vb, pa0, pa1, pa2, pa3); pv_one<1>(o[1], vb, pa0, pa1, pa2, pa3); pv_one<2>(o[2], vb, pa0, pa1, pa2, pa3); pv_one<3>(o[3], vb, pa0, pa1, pa2, pa3);
}
template <int LDQ, int LDK, int LDO>
__device__ __forceinline__ void attn_dense_body(const bf16_t* __restrict__ Qb, const bf16_t* __restrict__ Kh, const bf16_t* __restrict__ Vh,
                                                bf16_t* __restrict__ Ob, int seq, char* lds, const int tid) {
  const int wid = tid >> 6, lane = tid & 63, r32 = lane & 31, hi = lane >> 5;
  bf16_t* V_lds = (bf16_t*)lds; bf16_t* K_lds = (bf16_t*)(lds + 2 * SHM_V);
  float* ws = (float*)(lds + 2 * SHM_V + 2 * SHM_K) + wid * 64; float* li_l = ws; float* al_l = ws + 32;
  float m_reg = -1e30f, l_reg = 0; f32x16 o[4] = {}; bf16x8 qr[8];
  const bf16_t* Qw = Qb + (long)(wid * QBLK + r32) * LDQ + hi * 8;
#pragma unroll
  for (int d0 = 0; d0 < 8; ++d0) qr[d0] = *reinterpret_cast<const bf16x8*>(Qw + d0 * 16);
  const int sr = tid >> 4, sc = (tid & 15) * 8, vst0 = v_st(sr, sc), vst1 = v_st(32 + sr, sc);
  const int vb0 = (int)(uintptr_t)V_lds + v_rd_base(lane);
  struct { bf16x8 vs0, vs1, ks0, ks1; } sr_[SDEPTH];
#define SLOAD(i, k0) do { sr_[i].vs0 = *reinterpret_cast<const bf16x8*>(&Vh[(long)((k0) + sr) * LDK + sc]); sr_[i].vs1 = *reinterpret_cast<const bf16x8*>(&Vh[(long)((k0) + 32 + sr) * LDK + sc]); \
    sr_[i].ks0 = *reinterpret_cast<const bf16x8*>(&Kh[(long)((k0) + sr) * LDK + sc]); sr_[i].ks1 = *reinterpret_cast<const bf16x8*>(&Kh[(long)((k0) + 32 + sr) * LDK + sc]); } while (0)
#define SWRITE(b, i) do { *(bf16x8*)((char*)V_lds + (b) * SHM_V + vst0) = sr_[i].vs0;          \
    *(bf16x8*)((char*)V_lds + (b) * SHM_V + vst1) = sr_[i].vs1; int kc = sc * 2;               \
    *(bf16x8*)((char*)K_lds + (b) * SHM_K + KSWZ(sr, kc)) = sr_[i].ks0;                       \
    *(bf16x8*)((char*)K_lds + (b) * SHM_K + KSWZ(32 + sr, kc)) = sr_[i].ks1; } while (0)
#define SWAIT() do { asm volatile("s_waitcnt vmcnt(4)" ::: "memory"); } while (0)
#define RESC(a) do { if (__any((a) < 1.f)) { if (hi == 0) al_l[r32] = (a); asm volatile("s_waitcnt lgkmcnt(0)" ::: "memory"); \
    for (int d = 0; d < 4; ++d) for (int r = 0; r < 16; ++r) o[d][r] *= al_l[crow(r, hi)]; } } while (0)
  f32x16 pA0, pA1, pB0, pB1; float mnA, mnB, alA, alB; bf16x8 pa0, pa1, pa2, pa3; const int NT = seq / KVBLK;
  constexpr int SE = 0, SO = SDEPTH - 1;
  SLOAD(SE, 0); asm volatile("s_waitcnt vmcnt(0)" ::: "memory"); SWRITE(0, SE); __syncthreads();
  qkt(pA0, pA1, K_lds, qr, r32, hi); partialSM(pA0, pA1, m_reg, mnA, alA);
  SLOAD(SO, KVBLK); if (2 < NT) SLOAD(SE, 2 * KVBLK);
  SWAIT(); SWRITE(1, SO); __syncthreads();
  for (int j = 1; j + 1 < NT; j += 2) {
    SBAR(); qkt(pB0, pB1, (bf16_t*)((char*)K_lds + SHM_K), qr, r32, hi);
    finishSM(pA0, pA1, alA, l_reg, pa0, pa1, pa2, pa3); SBAR();
    SLOAD(SO, (j + SDEPTH) * KVBLK); SBAR();
    pv_d0(o, vb0, pa0, pa1, pa2, pa3); partialSM(pB0, pB1, m_reg, mnB, alB);
    __syncthreads(); SWAIT(); SWRITE(0, SE);
    RESC(alB); __syncthreads();
    SBAR(); qkt(pA0, pA1, K_lds, qr, r32, hi);
    finishSM(pB0, pB1, alB, l_reg, pa0, pa1, pa2, pa3); SBAR();
    if (j + 3 < NT) SLOAD(SE, (j + 1 + SDEPTH) * KVBLK); SBAR();
    pv_d0(o, vb0 + (int)SHM_V, pa0, pa1, pa2, pa3); partialSM(pA0, pA1, m_reg, mnA, alA);
    __syncthreads(); SWAIT(); SWRITE(1, SO);
    RESC(alA); __syncthreads();
  }
  SBAR(); qkt(pB0, pB1, (bf16_t*)((char*)K_lds + SHM_K), qr, r32, hi);
  finishSM(pA0, pA1, alA, l_reg, pa0, pa1, pa2, pa3); SBAR();
  pv_d0(o, vb0, pa0, pa1, pa2, pa3); partialSM(pB0, pB1, m_reg, mnB, alB);
  __syncthreads(); RESC(alB);
  finishSM(pB0, pB1, alB, l_reg, pa0, pa1, pa2, pa3); SBAR();
  pv_d0(o, vb0 + (int)SHM_V, pa0, pa1, pa2, pa3);
  if (hi == 0) li_l[r32] = l_reg; asm volatile("s_waitcnt lgkmcnt(0)" ::: "memory");
  float rli[16];
#pragma unroll
  for (int r = 0; r < 16; ++r) rli[r] = __builtin_amdgcn_rcpf(li_l[crow(r, hi)]);
  GAS bf16_t* Ow = (GAS bf16_t*)(Ob + (long)(wid * QBLK + 4 * hi) * LDO + r32);
  asm volatile("" : "+v"(Ow));
#pragma unroll
  for (int r = 0; r < 16; ++r) { GAS bf16_t* rowp = Ow + (long)((r & 3) + 8 * (r >> 2)) * LDO;
    for (int d0 = 0; d0 < 4; ++d0) rowp[d0 * 32] = (bf16_t)(cvtpk(o[d0][r] * rli[r], 0.f) & 0xffffu); }
#undef SLOAD
#undef SWRITE
#undef SWAIT
#undef RESC
}
#undef KSWZ
#undef SBAR
}

__device__ __forceinline__ void attn_b_unit(const Frame& F, int b, int h, int qb) {
    const bf16_t* Q = F_QKV + (size_t)(b * SEQ + qb * 256) * QKVW + C_QB + h * HD;
    const bf16_t* K = F_QKV + (size_t)(b * SEQ) * QKVW + C_KB + (h / 3) * HD;
    bf16_t* O = F_OALL + (size_t)(b * SEQ + qb * 256) * OALLW + O_B + h * HD;
    int t_ = F.tid; asm volatile("" : "+v"(t_));
    attnb::attn_dense_body<QKVW, QKVW, OALLW>(Q, K, K + (C_VB - C_KB), O, SEQ, (char*)F.lds, t_);
}
__device__ __forceinline__ void attn_c_unit(const Frame& F, int b, int h, int qb) {
    const bf16_t* Q = F_QKV + (size_t)(b * SEQ + qb * 256) * QKVW + C_QC + h * HD;
    const bf16_t* K = F_MKV + (size_t)(b * NMEM) * 1024 + h * HD;
    bf16_t* O = F_OALL + (size_t)(b * SEQ + qb * 256) * OALLW + O_C + h * HD;
    int t_ = F.tid; asm volatile("" : "+v"(t_));
    attnb::attn_dense_body<QKVW, 1024, OALLW>(Q, K, K + 512, O, NMEM, (char*)F.lds, t_);
}
typedef short v4i16_t __attribute__((ext_vector_type(4)));
__device__ __forceinline__ void attn_item_a(const Frame& F, int item, int lane, LAS unsigned char* vl) {
    const int r32 = lane & 31, hi = lane >> 5;
    const int hh = item / 512, idx = item % 512, g = hh >> 1; const int dil = g == 0 ? 1 : (g == 1 ? 4 : 16); const int L = SEQ / dil, nqb = L / 32;
    const int n = idx / nqb, qb = idx % nqb, b = n / dil, rr = n % dil;
    const int tok0 = b * SEQ + rr, q0 = qb * 32, tile0 = q0 - 64;
    const bf16_t* base = F_QKV;
    const int qtok = tok0 + (q0 + r32) * dil;
    const bf16_t* qp = base + (size_t)qtok * QKVW + C_QA + hh * HD + 8 * hi;
    bf16x8 qf[8], kfA[8]; u32x4 vr[8];
#define A_LOADK(KF, pos0_) do { int kp_ = (pos0_) + r32; kp_ = kp_ < 0 ? 0 : (kp_ >= L ? L - 1 : kp_); const bf16_t* kptr_ = base + (size_t)(tok0 + kp_ * dil) * QKVW + C_KA + hh * HD + 8 * hi; \
        _Pragma("unroll") for (int s = 0; s < 8; ++s) KF[s] = *(const bf16x8*)(kptr_ + 16 * s); } while (0)
#define A_LOADV(VR, pos0_) do { _Pragma("unroll") for (int i = 0; i < 8; ++i) { int kp_ = (pos0_) + 4 * i + (lane >> 4); kp_ = kp_ < 0 ? 0 : (kp_ >= L ? L - 1 : kp_); \
        VR[i] = *(const u32x4*)(base + (size_t)(tok0 + kp_ * dil) * QKVW + C_VA + hh * HD + 8 * (lane & 15)); } } while (0)
    A_LOADK(kfA, tile0); A_LOADV(vr, tile0);
#pragma unroll
    for (int s = 0; s < 8; ++s) qf[s] = *(const bf16x8*)(qp + 16 * s);
    LAS float* bl = (LAS float*)(vl + 8704);
    { const float* bT = F_biasT + hh * 160; for (int i = lane; i < 160; i += 64) bl[i] = bT[i]; }
    f32x16 o[4];
#pragma unroll
    for (int d = 0; d < 4; ++d)
#pragma unroll
        for (int r = 0; r < 16; ++r) o[d][r] = 0.f;
    float mrun = -1e30f, lrun = 0.f;
    LAS unsigned char* vwr = vl + (lane >> 4) * 272 + (lane & 15) * 16;
    LAS unsigned char* vrd = vl + (4 * hi + ((lane & 15) >> 2)) * 272 + (16 * ((lane >> 4) & 1) + 4 * (lane & 3)) * 2;
#pragma unroll 1
    for (int j = 0; j < 5; ++j) {
        const int pos0 = tile0 + 32 * j;
#pragma unroll
        for (int i = 0; i < 8; ++i) *(LAS u32x4*)(vwr + i * 4 * 272) = vr[i];
        if (j + 1 < 5) { A_LOADV(vr, pos0 + 32); }
        f32x16 p;
#pragma unroll
        for (int r = 0; r < 16; ++r) p[r] = 0.f;
#pragma unroll
        for (int s = 0; s < 8; ++s) p = __builtin_amdgcn_mfma_f32_32x32x16_bf16(kfA[s], qf[s], p, 0, 0, 0);
        if (j + 1 < 5) { A_LOADK(kfA, pos0 + 32); }
        bool valid[16]; float tmax = -1e30f;
#pragma unroll
        for (int r = 0; r < 16; ++r) { const int kk = pos0 + crow(r, hi), rel = kk - (q0 + r32); valid[r] = (kk >= 0) && (kk < L) && (rel >= -64) && (rel <= 64);
            const int bi = rel < -64 ? 0 : (rel > 64 ? 128 : rel + 64); p[r] += bl[bi]; if (valid[r]) tmax = fmaxf(tmax, p[r]); }
        tmax = fmaxf(tmax, __shfl_xor(tmax, 32));
        const float mnew = fmaxf(mrun, tmax), alpha = __builtin_amdgcn_exp2f(mrun - mnew);
        float rs = 0.f;
#pragma unroll
        for (int r = 0; r < 16; ++r) { const float e_ = valid[r] ? __builtin_amdgcn_exp2f(p[r] - mnew) : 0.f; p[r] = e_; rs += e_; }
        rs += __shfl_xor(rs, 32);
        lrun = lrun * alpha + rs; mrun = mnew;
#pragma unroll
        for (int d = 0; d < 4; ++d)
#pragma unroll
            for (int r = 0; r < 16; ++r) o[d][r] *= alpha;
        unsigned pw[8];
#pragma unroll
        for (int i = 0; i < 8; ++i) pw[i] = cvtpk(p[2 * i], p[2 * i + 1]);
#pragma unroll
        for (int s = 0; s < 2; ++s) {
            const bf16x8 pb = __builtin_bit_cast(bf16x8, (u32x4){pw[4 * s], pw[4 * s + 1], pw[4 * s + 2], pw[4 * s + 3]});
#pragma unroll
            for (int d = 0; d < 4; ++d) {
                const v4i16_t lo = __builtin_amdgcn_ds_read_tr16_b64_v4i16((LAS v4i16_t*)(vrd + (16 * s) * 272 + d * 64));
                const v4i16_t hv = __builtin_amdgcn_ds_read_tr16_b64_v4i16((LAS v4i16_t*)(vrd + (16 * s + 8) * 272 + d * 64));
                const bf16x8 vf = {lo[0], lo[1], lo[2], lo[3], hv[0], hv[1], hv[2], hv[3]};
                o[d] = __builtin_amdgcn_mfma_f32_32x32x16_bf16(vf, pb, o[d], 0, 0, 0); }
        }
    }
#undef A_LOADK
#undef A_LOADV
    const float inv = 1.0f / lrun;
    bf16_t* op = F_OG + (size_t)qtok * 768 + hh * HD;
#pragma unroll
    for (int d = 0; d < 4; ++d)
#pragma unroll
        for (int r = 0; r < 16; r += 2) { const int dd = 32 * d + crow(r, hi); *(unsigned*)(op + dd) = cvtpk(o[d][r] * inv, o[d][r + 1] * inv); }
    if (hi == 0) F_lse[(size_t)qtok * 6 + hh] = mrun + __builtin_amdgcn_logf(lrun);
}
__device__ __forceinline__ void attn_a_chunk(const Frame& F, int ch) {
    const int b = ch >> 4, s = (ch >> 3) & 1, c8 = ch & 7;
    int ln_ = F.lane; asm volatile("" : "+v"(ln_));
    LAS unsigned char* vl = F.lds + F.wave * 16384;
    for (int j = F.wave; j < 48; j += 8) { const int g = j >> 4, k = j & 15, hh = 2 * g + s;
        int idx;
        if (g == 0) idx = b * 128 + 16 * c8 + k; else if (g == 1) idx = (b * 4 + (k >> 2)) * 32 + 4 * c8 + (k & 3); else idx = (b * 16 + k) * 8 + c8;
        attn_item_a(F, hh * 512 + idx, ln_, vl); }
    VM_WAIT(); __syncthreads();
    if (F.tid == 0) { __builtin_amdgcn_fence(__ATOMIC_ACQUIRE, "agent"); VM_WAIT(); }
    __syncthreads();
    const int lane = ln_;
    const int tb = b * SEQ + 512 * c8 + F.wave;
    float w0, w1, w2;
    { const size_t t = (size_t)(tb + 8 * lane); const float l0 = F_lse[t * 6 + s], l1 = F_lse[t * 6 + 2 + s], l2 = F_lse[t * 6 + 4 + s];
      const float mx = fmaxf(l0, fmaxf(l1, l2)); w0 = __builtin_amdgcn_exp2f(l0 - mx); w1 = __builtin_amdgcn_exp2f(l1 - mx); w2 = __builtin_amdgcn_exp2f(l2 - mx);
      const float inv = 1.0f / (w0 + w1 + w2); w0 *= inv; w1 *= inv; w2 *= inv; }
    for (int j0 = 0; j0 < 64; j0 += 8) {
        unsigned ra[8], rb[8], rc[8];
#pragma unroll
        for (int q = 0; q < 8; ++q) { const bf16_t* og = F_OG + (size_t)(tb + 8 * (j0 + q)) * 768 + s * HD; ra[q] = ((const unsigned*)og)[lane]; rb[q] = ((const unsigned*)(og + 256))[lane]; rc[q] = ((const unsigned*)(og + 512))[lane]; }
#pragma unroll
        for (int q = 0; q < 8; ++q) { const int j = j0 + q;
            const float a0 = __builtin_bit_cast(float, __builtin_amdgcn_readlane(__builtin_bit_cast(int, w0), j)), a1 = __builtin_bit_cast(float, __builtin_amdgcn_readlane(__builtin_bit_cast(int, w1), j)),
                        a2 = __builtin_bit_cast(float, __builtin_amdgcn_readlane(__builtin_bit_cast(int, w2), j));
            ((unsigned*)(F_OALL + (size_t)(tb + 8 * j) * OALLW + O_A + s * HD))[lane] =
                cvtpk(a0 * bf_lo(ra[q]) + a1 * bf_lo(rb[q]) + a2 * bf_lo(rc[q]), a0 * bf_hi(ra[q]) + a1 * bf_hi(rb[q]) + a2 * bf_hi(rc[q])); }
    }
    __syncthreads();
}
__device__ __forceinline__ void p2_attention(const Frame& F) {
    constexpr int NBI = NB * 6 * 16, NCI = NB * 4 * 16, NCH = 64;
    int u0, ustep, nu, bh0 = -1, c0 = 0, cstep = 1, nc = 0, a0 = 0, astep = 1, na = 0, fw = -1, fn = 1;
    if (F.G == 256) { const int xg = F.vcu >> 5, li = F.vcu & 31; bh0 = xg;
        if (li < 24) { u0 = 2 * li; ustep = 1; nu = 2; }
        else { u0 = 0; ustep = 1; nu = 0; const int i = li - 24, lc = xg * 8 + i; c0 = 4 * lc; nc = 4; a0 = (xg >> 1) * 16 + (xg & 1) * 8 + i; na = 1; fw = lc * 8 + F.wave; fn = 512; } }
    else { u0 = F.vcu; ustep = F.G; nu = (NBI - F.vcu + F.G - 1) / F.G; if (nu < 0) nu = 0; c0 = F.vcu; cstep = F.G; nc = (NCI - F.vcu + F.G - 1) / F.G; if (nc < 0) nc = 0;
        a0 = F.vcu; astep = F.G; na = (NCH - F.vcu + F.G - 1) / F.G; if (na < 0) na = 0; fw = F.vcu * 8 + F.wave; fn = F.G * 8; }
    for (int k = 0; k < nu; ++k) { const int u = u0 + k * ustep; int b, h, qb;
        if (bh0 >= 0) { b = bh0 >> 1; h = (bh0 & 1) * 3 + (u >> 4); qb = u & 15; } else { const int bh = u >> 4; b = bh / 6; h = bh % 6; qb = u & 15; }
        attn_b_unit(F, b, h, qb); }
    for (int k = 0; k < nc; ++k) { const int c = c0 + k * cstep, bh = c >> 4; attn_c_unit(F, bh >> 2, bh & 3, c & 15); }
    __syncthreads();
    for (int k = 0; k < na; ++k) attn_a_chunk(F, a0 + k * astep);
}


enum Phase { PH_PRO = 0, PH_PROJ, PH_ATTN, PH_BR, PH_WO, PH_FFI, PH_FFO, PH_COUNT };

__global__ void __launch_bounds__(512, 2) mk_fwd(Args args) {
    extern __shared__ __attribute__((aligned(16))) unsigned char lds_raw[];
    Frame F0;
    F0.lds = (LAS unsigned char*)lds_raw;
    F0.tid = threadIdx.x; F0.lane = F0.tid & 63; F0.wave = __builtin_amdgcn_readfirstlane(F0.tid >> 6);
    F0.G = gridDim.x; { const int bx = blockIdx.x; F0.vcu = (F0.G % 8 == 0) ? (bx % 8) * (F0.G / 8) + bx / 8 : bx; }
    F0.a = (const __attribute__((address_space(4))) Args*)__builtin_amdgcn_kernarg_segment_ptr(); F0.ws = (GAS unsigned char*)args.ws; F0.out = (GAS float*)args.out;

    for (int u = F0.tid; u < (LDS_BYTES - LDSCTL_OFF) / 4; u += 512) ((LAS unsigned*)(F0.lds + LDSCTL_OFF))[u] = 0u;
    __syncthreads();
    const int lo = args.ph_lo, hi = args.ph_hi;
    const bool use_bar = (hi - lo) > 1;
    XcdBarrier bar; bar.bar = ((unsigned*)(GAS unsigned*)(F0.ws + WS_CTL)) + CW_BAR; bar.x = 0; bar.st = (volatile LAS unsigned*)(F0.lds + LDSCTL_OFF + 64);
    if (use_bar) bar = xcd_barrier_post(((unsigned*)(GAS unsigned*)(F0.ws + WS_CTL)) + CW_BAR, (volatile LAS unsigned*)(F0.lds + LDSCTL_OFF + 64));

    for (int ph2 = lo * 2; ph2 < hi * 2; ++ph2) {
        const int ph = ph2 >> 1; if ((ph2 & 1) && ph != PROBE_DUP) continue;
        if (ph2 != lo * 2) xcd_barrier(bar);
        Frame F = F0;
        { int wv_ = F0.wave; asm volatile("" : "+s"(wv_)); int ln_ = (int)__builtin_amdgcn_mbcnt_hi(~0u, __builtin_amdgcn_mbcnt_lo(~0u, 0u)); asm volatile("" : "+v"(ln_));
          F.wave = wv_; F.lane = ln_; F.tid = wv_ * 64 + ln_; }
        { GAS unsigned char* w_ = F0.ws; GAS float* o_ = F0.out; int g_ = F0.G, v_ = F0.vcu; const __attribute__((address_space(4))) Args* a_ = F0.a; asm volatile("" : "+s"(w_), "+s"(o_), "+s"(g_), "+s"(v_), "+s"(a_)); F.ws = w_; F.out = o_; F.G = g_; F.vcu = v_; F.a = a_; }
        if (ph == PH_PRO) {
            p0_prologue(F);
        } else if (ph == PH_ATTN) {
            p2_attention(F);
        } else {
            const int ncall = 1;
            for (int c = 0; c < ncall; ++c) {
                pg8::Gemm g; int mode;
                if (ph == PH_PROJ) { g = pg8::Gemm{F_HB1, F_Win, DM, DM, T, INW, DM, F_MEMN, T / 256}; mode = E_PROJ; }
                else if (ph == PH_BR) { g = pg8::Gemm{F_OALL, F_Wbr, OALLW, OALLW, T, DM, OALLW, nullptr, 1 << 20}; mode = E_BR; }
                else if (ph == PH_WO) { g = pg8::Gemm{F_GATES, F_Wo, GATEW, DM, T, DM, DM, nullptr, 1 << 20}; mode = E_WO; }
                else if (ph == PH_FFI) { g = pg8::Gemm{F_X1B, F_Wfi, DM, DM, T, 2 * DFF, DM, nullptr, 1 << 20}; mode = E_FFI; }
                else { g = pg8::Gemm{F_ACT, F_Wfo, DFF, DFF, T, DM, DFF, nullptr, 1 << 20}; mode = E_FFO; }
                pg8::StaticOrder S; S.init(g.M, g.N, F.G, (int)blockIdx.x, (g.N > 4096) ? WGM_BIG : WGM_SMALL); S.extra = (ph == PH_PROJ) ? 16 : 0;
                EpiRT E{mode, &F, (PROBE_DUP == ph) && !(ph2 & 1)};
                pg8::gemm_phase<EpiRT>(F.lds, g, S, E, F.tid);
            }
            if (ph == PH_PROJ) { const int nmem = F.G > 16 ? 16 : 0;
                if ((int)blockIdx.x >= nmem) p0_convert_late(F, (int)blockIdx.x - nmem, F.G - nmem); }
        }
    }
}

extern "C" void kernel_launch(void* const* d_in, const int* in_sizes, int n_in, void* d_out, int out_size, void* d_ws, size_t ws_size, hipStream_t stream) {
    static int grid = 0;
    if (grid == 0) {
        if (n_in != 20 || in_sizes[0] != T * DM || out_size != T * DM || ws_size < WS_END) { fprintf(stderr, "kernel_launch: unexpected shapes (n_in %d in0 %d out %d ws %zu)\n", n_in, n_in > 0 ? in_sizes[0] : -1, out_size, ws_size); grid = -1; return; }
        int dev = 0, cus = 0, per_cu = 0;
        if (hipGetDevice(&dev) != hipSuccess || hipDeviceGetAttribute(&cus, hipDeviceAttributeMultiprocessorCount, dev) != hipSuccess) { grid = -1; return; }
        if (hipFuncSetAttribute((const void*)mk_fwd, hipFuncAttributeMaxDynamicSharedMemorySize, LDS_BYTES) != hipSuccess) { fprintf(stderr, "kernel_launch: hipFuncSetAttribute failed\n"); grid = -1; return; }
        if (hipOccupancyMaxActiveBlocksPerMultiprocessor(&per_cu, (const void*)mk_fwd, 512, LDS_BYTES) != hipSuccess || per_cu < 1) { fprintf(stderr, "kernel_launch: occupancy query says %d blocks per CU\n", per_cu); (void)hipGetLastError(); grid = -1; return; }
        grid = cus;
    }
    if (grid < 0) return;
    (void)hipMemsetAsync((char*)d_ws + WS_CTL, 0, CTL_ZERO_BYTES, stream);
    Args a{};
    for (int i = 0; i < 20; ++i) a.in[i] = (const float*)d_in[i];
    a.out = (float*)d_out; a.ws = (unsigned char*)d_ws;
    if (MK_N_LAUNCHES == 1) { a.ph_lo = 0; a.ph_hi = PH_COUNT; hipLaunchKernelGGL(mk_fwd, dim3(grid), dim3(512), LDS_BYTES, stream, a); }
    else for (int ph = 0; ph < PH_COUNT; ++ph) { a.ph_lo = ph; a.ph_hi = ph + 1; hipLaunchKernelGGL(mk_fwd, dim3(grid), dim3(512), LDS_BYTES, stream, a); }
}
```
